# Optimizing an MI355X kernel written in HIP

```python
import jax, jax.numpy as jnp
from jax import lax
import numpy as np


D_MODEL = 1024
BATCH = 16
SEQ = 2048
DEPTH = 2

HEAD_DIM = 64
NSA_HEADS = 8
NSA_KV_HEADS = 2
NSA_GROUP = NSA_HEADS // NSA_KV_HEADS
NSA_WIDTH = NSA_HEADS * HEAD_DIM
NSA_KV_WIDTH = NSA_KV_HEADS * HEAD_DIM
CMP_BLOCK = 32
CMP_STRIDE = 16
CMP_HIDDEN = 256
SLC_BLOCK = 64
SLC_TOPK = 8
WINDOW = 512
NSA_Q_CHUNK = 128
MOBA_HEADS = 8
MOBA_WIDTH = MOBA_HEADS * HEAD_DIM
MOBA_BLOCK = 256
MOBA_TOPK = 3
MOBA_Q_CHUNK = 32
D_FF = 2816
TOTAL_HEADS = NSA_HEADS + MOBA_HEADS
NEG_INF = -1e30
FORCE = 1e9
IN_SPLITS = (NSA_WIDTH, NSA_KV_WIDTH, NSA_KV_WIDTH, NSA_KV_WIDTH, NSA_KV_WIDTH, NSA_KV_WIDTH, NSA_KV_WIDTH,
             3 * NSA_HEADS, MOBA_WIDTH, MOBA_WIDTH, MOBA_WIDTH, D_MODEL, D_MODEL)
IN_COLS = sum(IN_SPLITS)

kernel_name = "hybrid_nsa_moba_macaron_alibi"


def rms_norm(x, g, eps=1e-6):
    xf = x.astype(jnp.float32)
    y = xf * lax.rsqrt(jnp.mean(xf * xf, axis=-1, keepdims=True) + eps)
    return (y * g.astype(jnp.float32)).astype(x.dtype)


def swiglu(x, w1, w3, w2):
    return (jax.nn.silu(x @ w1) * (x @ w3)) @ w2


def masked_softmax(s, mask):
    p = jax.nn.softmax(jnp.where(mask, s, NEG_INF), axis=-1)
    return jnp.where(mask, p, 0.0)


def alibi_slopes():
    s = jnp.asarray((2.0 ** (-8.0 * np.arange(1, TOTAL_HEADS + 1) / TOTAL_HEADS)).astype(np.float32))
    return s[0::2], s[1::2]


def split_heads(t, n_heads):
    b, s, _ = t.shape
    return t.reshape(b, s, n_heads, HEAD_DIM).transpose(0, 2, 1, 3)


def gather_blocks(blocks, idx):
    return jax.vmap(jax.vmap(lambda kb, ii: kb[ii]))(blocks, idx)


def compress_kv(t, pos, w1, w2):
    b, g, s, dh = t.shape
    r = CMP_BLOCK // CMP_STRIDE
    n_chunks = s // CMP_STRIDE
    n_cmp = n_chunks - r + 1
    ch = t.reshape(b, g, n_chunks, CMP_STRIDE, dh)
    blocks = jnp.concatenate([ch[:, :, j:j + n_cmp] for j in range(r)], axis=3)
    flat = (blocks + pos).reshape(b, g, n_cmp, CMP_BLOCK * dh)
    return jax.nn.gelu(flat @ w1) @ w2


def nsa_mixer(q, k_cmp, v_cmp, k_slc, v_slc, k_win, v_win, gates, g_qk, cmp_pos, cmp_w1, cmp_w2, slopes):
    b, s, _ = q.shape
    f32 = jnp.float32
    scale = HEAD_DIM ** -0.5
    qh = q.reshape(b, s, NSA_KV_HEADS, NSA_GROUP, HEAD_DIM).transpose(0, 2, 3, 1, 4)
    qh = rms_norm(qh, g_qk[0])
    slope = slopes.reshape(NSA_KV_HEADS, NSA_GROUP)[None, :, :, None, None]
    pos_t = jnp.arange(s, dtype=jnp.int32)

    kc = rms_norm(compress_kv(split_heads(k_cmp, NSA_KV_HEADS), cmp_pos[0], cmp_w1[0], cmp_w2[0]), g_qk[1])
    vc = compress_kv(split_heads(v_cmp, NSA_KV_HEADS), cmp_pos[1], cmp_w1[1], cmp_w2[1])
    n_cmp = kc.shape[2]
    c_start = jnp.arange(n_cmp, dtype=jnp.int32) * CMP_STRIDE
    c_valid = (c_start[None, :] + CMP_BLOCK - 1) <= pos_t[:, None]
    c_dist = pos_t[:, None].astype(f32) - (c_start.astype(f32) + (CMP_BLOCK - 1) / 2)[None, :]
    s_cmp = jnp.einsum('bgrsd,bgcd->bgrsc', qh, kc).astype(f32) * scale - slope * c_dist
    p_cmp = masked_softmax(s_cmp, c_valid)
    o_cmp = jnp.einsum('bgrsc,bgcd->bgrsd', p_cmp.astype(vc.dtype), vc)

    n_slc = s // SLC_BLOCK
    ci = np.arange(n_cmp)[:, None] * CMP_STRIDE
    sj = np.arange(n_slc)[None, :] * SLC_BLOCK
    overlap = np.clip(np.minimum(ci + CMP_BLOCK, sj + SLC_BLOCK) - np.maximum(ci, sj), 0, None)
    cmp_to_slc = jnp.asarray((overlap / CMP_BLOCK).astype(np.float32))
    imp = jnp.einsum('bgrsc,cj->bgsj', p_cmp, cmp_to_slc)
    blk = jnp.arange(n_slc, dtype=jnp.int32)[None, :]
    cur = (pos_t // SLC_BLOCK)[:, None]
    forced = (blk == 0) | (blk == cur) | (blk == cur - 1)
    sel_score = jnp.where(forced, FORCE, jnp.where(blk <= cur, imp, NEG_INF))
    n_sel = min(SLC_TOPK, n_slc)
    _, sel_idx = lax.top_k(sel_score, n_sel)

    ks_blocks = rms_norm(split_heads(k_slc, NSA_KV_HEADS), g_qk[2]).reshape(b, NSA_KV_HEADS, n_slc, SLC_BLOCK, HEAD_DIM)
    vs_blocks = split_heads(v_slc, NSA_KV_HEADS).reshape(b, NSA_KV_HEADS, n_slc, SLC_BLOCK, HEAD_DIM)
    pad = ((0, 0), (0, 0), (WINDOW, 0), (0, 0))
    kw_pad = jnp.pad(rms_norm(split_heads(k_win, NSA_KV_HEADS), g_qk[3]), pad)
    vw_pad = jnp.pad(split_heads(v_win, NSA_KV_HEADS), pad)
    n_tok = n_sel * SLC_BLOCK

    def chunk(c):
        start = c * NSA_Q_CHUNK
        t = start + jnp.arange(NSA_Q_CHUNK, dtype=jnp.int32)
        qc = lax.dynamic_slice_in_dim(qh, start, NSA_Q_CHUNK, axis=3)
        idx = lax.dynamic_slice_in_dim(sel_idx, start, NSA_Q_CHUNK, axis=2)
        ks = gather_blocks(ks_blocks, idx).reshape(b, NSA_KV_HEADS, NSA_Q_CHUNK, n_tok, HEAD_DIM)
        vs = gather_blocks(vs_blocks, idx).reshape(b, NSA_KV_HEADS, NSA_Q_CHUNK, n_tok, HEAD_DIM)
        s_pos = (idx[..., None] * SLC_BLOCK + jnp.arange(SLC_BLOCK, dtype=jnp.int32)).reshape(b, NSA_KV_HEADS, NSA_Q_CHUNK, n_tok)
        s_dist = (t[:, None] - s_pos)[:, :, None]
        sc = jnp.einsum('bgrqd,bgqkd->bgrqk', qc, ks).astype(f32) * scale - slope * s_dist.astype(f32)
        p = masked_softmax(sc, s_dist >= 0)
        o_s = jnp.einsum('bgrqk,bgqkd->bgrqd', p.astype(vs.dtype), vs)
        kwc = lax.dynamic_slice_in_dim(kw_pad, start, NSA_Q_CHUNK + WINDOW, axis=2)
        vwc = lax.dynamic_slice_in_dim(vw_pad, start, NSA_Q_CHUNK + WINDOW, axis=2)
        w_pos = start - WINDOW + jnp.arange(NSA_Q_CHUNK + WINDOW, dtype=jnp.int32)
        w_dist = t[:, None] - w_pos[None, :]
        w_mask = (w_dist >= 0) & (w_dist < WINDOW) & (w_pos[None, :] >= 0)
        sw = jnp.einsum('bgrqd,bgkd->bgrqk', qc, kwc).astype(f32) * scale - slope * w_dist.astype(f32)
        pw = masked_softmax(sw, w_mask)
        o_w = jnp.einsum('bgrqk,bgkd->bgrqd', pw.astype(vwc.dtype), vwc)
        return o_s, o_w

    o_slc, o_win = lax.map(chunk, jnp.arange(s // NSA_Q_CHUNK, dtype=jnp.int32))

    def unchunk(o):
        return o.transpose(1, 2, 3, 0, 4, 5).reshape(b, NSA_KV_HEADS, NSA_GROUP, s, HEAD_DIM)

    g = jax.nn.sigmoid(gates.astype(f32)).reshape(b, s, NSA_KV_HEADS, NSA_GROUP, 3).transpose(0, 2, 3, 1, 4).astype(q.dtype)
    o = g[..., 0:1] * o_cmp + g[..., 1:2] * unchunk(o_slc) + g[..., 2:3] * unchunk(o_win)
    return o.transpose(0, 3, 1, 2, 4).reshape(b, s, NSA_WIDTH)


def moba_mixer(q, k, v, g_qk, slopes):
    b, s, _ = q.shape
    f32 = jnp.float32
    scale = HEAD_DIM ** -0.5
    qh = rms_norm(split_heads(q, MOBA_HEADS), g_qk[0])
    kh = rms_norm(split_heads(k, MOBA_HEADS), g_qk[1])
    vh = split_heads(v, MOBA_HEADS)
    n_blk = -(-s // MOBA_BLOCK)
    pad = ((0, 0), (0, 0), (0, n_blk * MOBA_BLOCK - s), (0, 0))
    k_pad = jnp.pad(kh, pad)
    v_pad = jnp.pad(vh, pad)
    kb = k_pad.reshape(b, MOBA_HEADS, n_blk, MOBA_BLOCK, HEAD_DIM)
    vb = v_pad.reshape(b, MOBA_HEADS, n_blk, MOBA_BLOCK, HEAD_DIM)
    k_mean = jnp.mean(kb.astype(f32), axis=3).astype(kh.dtype)
    pos_t = jnp.arange(s, dtype=jnp.int32)
    cur = (pos_t // MOBA_BLOCK)[:, None]
    past = jnp.arange(n_blk, dtype=jnp.int32)[None, :] < cur
    gate = jnp.einsum('bhsd,bhnd->bhsn', qh, k_mean).astype(f32)
    n_top = min(MOBA_TOPK, n_blk)
    _, top_idx = lax.top_k(jnp.where(past, gate, NEG_INF), n_top)
    top_valid = top_idx < cur
    slope = slopes[None, :, None, None]
    n_tok = n_top * MOBA_BLOCK

    def chunk(c):
        start = c * MOBA_Q_CHUNK
        t = start + jnp.arange(MOBA_Q_CHUNK, dtype=jnp.int32)
        qc = lax.dynamic_slice_in_dim(qh, start, MOBA_Q_CHUNK, axis=2)
        idx = lax.dynamic_slice_in_dim(top_idx, start, MOBA_Q_CHUNK, axis=2)
        valid = lax.dynamic_slice_in_dim(top_valid, start, MOBA_Q_CHUNK, axis=2)
        kt = gather_blocks(kb, idx).reshape(b, MOBA_HEADS, MOBA_Q_CHUNK, n_tok, HEAD_DIM)
        vt = gather_blocks(vb, idx).reshape(b, MOBA_HEADS, MOBA_Q_CHUNK, n_tok, HEAD_DIM)
        t_pos = (idx[..., None] * MOBA_BLOCK + jnp.arange(MOBA_BLOCK, dtype=jnp.int32)).reshape(b, MOBA_HEADS, MOBA_Q_CHUNK, n_tok)
        t_dist = (t[:, None] - t_pos).astype(f32)
        t_mask = jnp.repeat(valid, MOBA_BLOCK, axis=-1)
        s_top = jnp.einsum('bhqd,bhqkd->bhqk', qc, kt).astype(f32) * scale - slope * t_dist
        own_start = (start // MOBA_BLOCK) * MOBA_BLOCK
        ko = lax.dynamic_slice_in_dim(k_pad, own_start, MOBA_BLOCK, axis=2)
        vo = lax.dynamic_slice_in_dim(v_pad, own_start, MOBA_BLOCK, axis=2)
        o_dist = t[:, None] - (own_start + jnp.arange(MOBA_BLOCK, dtype=jnp.int32))[None, :]
        s_own = jnp.einsum('bhqd,bhkd->bhqk', qc, ko).astype(f32) * scale - slope * o_dist.astype(f32)
        sc = jnp.concatenate([s_top, s_own], axis=-1)
        mask = jnp.concatenate([t_mask, jnp.broadcast_to(o_dist >= 0, (b, MOBA_HEADS, MOBA_Q_CHUNK, MOBA_BLOCK))], axis=-1)
        p = masked_softmax(sc, mask).astype(vh.dtype)
        return (jnp.einsum('bhqk,bhqkd->bhqd', p[..., :n_tok], vt)
                + jnp.einsum('bhqk,bhkd->bhqd', p[..., n_tok:], vo))

    o = lax.map(chunk, jnp.arange(s // MOBA_Q_CHUNK, dtype=jnp.int32))
    return o.transpose(1, 0, 3, 2, 4).reshape(b, s, MOBA_WIDTH)


def token_mixing(h, w_in, g_qk_nsa, g_qk_moba, cmp_pos, cmp_w1, cmp_w2, w_up_nsa, w_up_moba, w_out, slopes_nsa, slopes_moba):
    proj = h @ w_in
    cuts = np.cumsum(IN_SPLITS)[:-1].tolist()
    (q_n, kc, vc, ks, vs, kw, vw, g_n, q_m, k_m, v_m, gate_n, gate_m) = jnp.split(proj, cuts, axis=-1)
    o_n = nsa_mixer(q_n, kc, vc, ks, vs, kw, vw, g_n, g_qk_nsa, cmp_pos, cmp_w1, cmp_w2, slopes_nsa)
    o_m = moba_mixer(q_m, k_m, v_m, g_qk_moba, slopes_moba)
    y = jax.nn.sigmoid(gate_n) * (o_n @ w_up_nsa) + jax.nn.sigmoid(gate_m) * (o_m @ w_up_moba)
    return y @ w_out


def setup_inputs(seed: int = 0) -> dict:
    key = jax.random.key(seed)
    ks = jax.random.split(key, 15)
    f32 = jnp.float32

    def w(k, shape, fan_in):
        return jax.random.normal(k, shape, f32) * fan_in ** -0.5

    return {
        "x": jax.random.normal(ks[0], (BATCH, SEQ, D_MODEL), f32),
        "norm_g": 1.0 + 0.02 * jax.random.normal(ks[1], (DEPTH, 3, D_MODEL), f32),
        "ffn_w1": w(ks[2], (DEPTH, 2, D_MODEL, D_FF), D_MODEL),
        "ffn_w3": w(ks[3], (DEPTH, 2, D_MODEL, D_FF), D_MODEL),
        "ffn_w2": w(ks[4], (DEPTH, 2, D_FF, D_MODEL), D_FF),
        "w_in": w(ks[5], (DEPTH, D_MODEL, IN_COLS), D_MODEL),
        "g_qk_nsa": 1.0 + 0.02 * jax.random.normal(ks[6], (DEPTH, 4, HEAD_DIM), f32),
        "g_qk_moba": 1.0 + 0.02 * jax.random.normal(ks[7], (DEPTH, 2, HEAD_DIM), f32),
        "cmp_pos": 0.02 * jax.random.normal(ks[8], (DEPTH, 2, CMP_BLOCK, HEAD_DIM), f32),
        "cmp_w1": w(ks[9], (DEPTH, 2, CMP_BLOCK * HEAD_DIM, CMP_HIDDEN), CMP_BLOCK * HEAD_DIM),
        "cmp_w2": w(ks[10], (DEPTH, 2, CMP_HIDDEN, HEAD_DIM), CMP_HIDDEN),
        "w_up_nsa": w(ks[11], (DEPTH, NSA_WIDTH, D_MODEL), NSA_WIDTH),
        "w_up_moba": w(ks[12], (DEPTH, MOBA_WIDTH, D_MODEL), MOBA_WIDTH),
        "w_out": w(ks[13], (DEPTH, D_MODEL, D_MODEL), D_MODEL),
    }


def reference(x, norm_g, ffn_w1, ffn_w3, ffn_w2, w_in, g_qk_nsa, g_qk_moba, cmp_pos, cmp_w1, cmp_w2, w_up_nsa, w_up_moba, w_out):
    slopes_nsa, slopes_moba = alibi_slopes()
    for l in range(DEPTH):
        x = x + 0.5 * swiglu(rms_norm(x, norm_g[l, 0]), ffn_w1[l, 0], ffn_w3[l, 0], ffn_w2[l, 0])
        x = x + token_mixing(rms_norm(x, norm_g[l, 1]), w_in[l], g_qk_nsa[l], g_qk_moba[l], cmp_pos[l],
                             cmp_w1[l], cmp_w2[l], w_up_nsa[l], w_up_moba[l], w_out[l], slopes_nsa, slopes_moba)
        x = x + 0.5 * swiglu(rms_norm(x, norm_g[l, 2]), ffn_w1[l, 1], ffn_w3[l, 1], ffn_w2[l, 1])
    return x
```

```cpp
#include <hip/hip_runtime.h>
#include <cstdio>
#include <cstdint>
namespace pg8 {
#define PG8_LAS __attribute__((address_space(3)))
typedef unsigned short bf16_t;
typedef short bf16x8 __attribute__((ext_vector_type(8)));
typedef float f32x4 __attribute__((ext_vector_type(4)));
typedef unsigned u32x4 __attribute__((ext_vector_type(4)));
constexpr int BM = 256, BK = 64, HALF = 128, HTB = HALF * BK * 2  , STAGE_BYTES = 8 * HTB, NXCD = 8, WGM = 8;

__host__ __device__ __forceinline__ int lds_byte(int r, int c) { const int st = (r >> 4) * 2 + (c >> 5), rr = r & 15, cc = c & 31, ob = rr * 64 + cc * 2; return st * 1024 + (ob ^ (((ob >> 9) & 1) << 5)); }
__host__ __device__ __forceinline__ void stage_rc(int b, int& R, int& C) { const int st = b / 1024, sb = b % 1024, swz = sb ^ (((sb >> 9) & 1) << 5); R = (st >> 1) * 16 + swz / 64; C = (st & 1) * 32 + (swz % 64) / 2; }
__host__ __device__ __forceinline__ int perm32(int rho) { const int n = rho >> 4, i = rho & 15; return 8 * (i >> 2) + 4 * n + (i & 3); }

struct Unit { int pm, pn; };
struct Gemm { const bf16_t* A; const bf16_t* Bt; int M, N, K, lda; };

struct StaticOrder {
    int nM, nN, nwg, G, c;
    __host__ __device__ void init(int M, int N, int G_, int c_) { nM = M / BM; nN = N / BM; nwg = nM * nN; G = G_; c = c_; }
    __host__ __device__ bool next(int i, Unit& u) const {
        const long L = (long)i * G + c; if (L >= nwg) return false;
        int wgid = (int)L; { const int q = nwg / NXCD, r = nwg % NXCD, xcd = wgid % NXCD, off = wgid / NXCD; wgid = (xcd < r ? xcd * (q + 1) : r * (q + 1) + (xcd - r) * q) + off; }
        const int nig = WGM * nN, gid = wgid / nig, fm = gid * WGM, gsz = (nM - fm) < WGM ? (nM - fm) : WGM;
        u.pm = fm + ((wgid % nig) % gsz); u.pn = (wgid % nig) / gsz; return true;
    }
    __device__ __forceinline__ void a_ready(const Unit&) const {}
    __device__ __forceinline__ void done(const Unit&) const {}
};

typedef float f32x2_cv __attribute__((ext_vector_type(2))); typedef __bf16 bf16x2_cv __attribute__((ext_vector_type(2)));
__device__ __forceinline__ unsigned cvt_pk_bf16(float lo, float hi) { f32x2_cv v = {lo, hi}; bf16x2_cv b = __builtin_convertvector(v, bf16x2_cv); return __builtin_bit_cast(unsigned, b); }
typedef float f32x2 __attribute__((ext_vector_type(2)));
template <class Epi, class Sched, bool ALIGN_EPI = false, bool SP2 = false>
__device__ __forceinline__ void gemm_phase(PG8_LAS unsigned char* lds, const Gemm g, const Sched& S, const Epi& E, const int wave_id  ) {
    int tid_; asm volatile("v_mbcnt_lo_u32_b32 %0, -1, 0\n\tv_mbcnt_hi_u32_b32 %0, -1, %0" : "=v"(tid_)); tid_ += wave_id * 64;
    const int tid = tid_, wid = __builtin_amdgcn_readfirstlane(tid >> 6), lane = tid & 63, wr = wid >> 2, wc = wid & 3, fr = lane & 15, fq = lane >> 4;
    const int K = g.K, nt = K / BK;
    unsigned voffA[2], voffB[2];
#pragma unroll
    for (int i = 0; i < 2; ++i) { int R, C; stage_rc(tid * 16 + i * 8192, R, C); const int Rb = Epi::PERM ? ((R & ~31) + perm32(R & 31)) : R;
        voffA[i] = (unsigned)(R * g.lda + C) * 2u; voffB[i] = (unsigned)(Rb * K + C) * 2u; }
    const size_t kstep = (size_t)(BK * 2);
    const size_t hstep = (size_t)HALF * K * 2;
    const size_t tstep = 2 * hstep; const size_t hstepA = (size_t)HALF * g.lda * 2, tstepA = 2 * hstepA;
    const unsigned ldsw = (unsigned)wid * 1024u;
    const int aoff = lds_byte(wr * 64 + fr, fq * 8), boff = lds_byte(wc * 32 + fr, fq * 8);
#define PG8_SA(b, h) (((b) * 2 + (h)) * HTB)
#define PG8_SB(b, h) ((4 + (b) * 2 + (h)) * HTB)
#define PG8_STAGE(bufoff, gbase, voff) do { _Pragma("unroll") for (int _i = 0; _i < 2; ++_i) \
        __builtin_amdgcn_global_load_lds((const unsigned*)((const char*)(gbase) + (voff)[_i]), (PG8_LAS unsigned*)(lds + (bufoff) + ldsw + _i * 8192), 16, 0, 0); } while (0)
#define PG8_LDA(dst, b, h) do { _Pragma("unroll") for (int m = 0; m < 4; ++m) _Pragma("unroll") for (int k = 0; k < 2; ++k) dst[m][k] = *(const PG8_LAS bf16x8*)(lds + PG8_SA(b, h) + aoff + m * 2048 + k * 1024); } while (0)
#define PG8_LDB(dst, b, h) do { _Pragma("unroll") for (int n = 0; n < 2; ++n) _Pragma("unroll") for (int k = 0; k < 2; ++k) dst[n][k] = *(const PG8_LAS bf16x8*)(lds + PG8_SB(b, h) + boff + n * 2048 + k * 1024); } while (0)
#define PG8_MMA(ai, bj, At, Bt) do { __builtin_amdgcn_s_setprio(1); _Pragma("unroll") for (int m = 0; m < 4; ++m) _Pragma("unroll") for (int n = 0; n < 2; ++n) _Pragma("unroll") for (int k = 0; k < 2; ++k) \
        acc[ai][bj][m][n] = __builtin_amdgcn_mfma_f32_16x16x32_bf16(Bt[n][k], At[m][k], acc[ai][bj][m][n], 0, 0, 0); __builtin_amdgcn_s_setprio(0); } while (0)
#define PG8_WAIT_V(n) asm volatile("s_waitcnt vmcnt(" #n ")" ::: "memory")
#define PG8_WAIT_L(n) asm volatile("s_waitcnt lgkmcnt(" #n ")" ::: "memory")
#define PG8_BAR __builtin_amdgcn_s_barrier()
#define PG8_SCHED __builtin_amdgcn_sched_barrier(0)
    Unit cur, nxt; int ui = 0;
    if (!S.next(0, cur)) return;
    f32x4 acc[2][2][4][2];
#pragma unroll
    for (int a = 0; a < 2; ++a)
#pragma unroll
        for (int b = 0; b < 2; ++b)
#pragma unroll
            for (int m = 0; m < 4; ++m)
#pragma unroll
                for (int n = 0; n < 2; ++n) acc[a][b][m][n] = (f32x4){0.f, 0.f, 0.f, 0.f};
    bf16x8 At[4][2], B0[2][2], B1[2][2];
    const char* cA = (const char*)g.A + (size_t)cur.pm * tstepA; const char* cB = (const char*)g.Bt + (size_t)cur.pn * tstep;
    S.a_ready(cur);
    if constexpr (SP2) {
        PG8_STAGE(PG8_SB(0, 0), cB, voffB); PG8_STAGE(PG8_SB(0, 1), cB + hstep, voffB); PG8_STAGE(PG8_SA(0, 0), cA, voffA); PG8_STAGE(PG8_SA(0, 1), cA + hstepA, voffA);
        if (wr == 1) PG8_BAR;
        PG8_WAIT_V(2); PG8_BAR;
        PG8_STAGE(PG8_SB(1, 0), cB + kstep, voffB); PG8_STAGE(PG8_SA(1, 0), cA + kstep, voffA); PG8_STAGE(PG8_SB(1, 1), cB + hstep + kstep, voffB);
        PG8_WAIT_V(6); PG8_BAR;
    } else {
        PG8_STAGE(PG8_SB(0, 0), cB, voffB); PG8_STAGE(PG8_SA(0, 0), cA, voffA); PG8_STAGE(PG8_SB(0, 1), cB + hstep, voffB); PG8_STAGE(PG8_SA(0, 1), cA + hstepA, voffA);
        if (wr == 1) PG8_BAR;
        PG8_WAIT_V(4); PG8_BAR;
        PG8_STAGE(PG8_SB(1, 0), cB + kstep, voffB); PG8_STAGE(PG8_SA(1, 0), cA + kstep, voffA); PG8_STAGE(PG8_SB(1, 1), cB + hstep + kstep, voffB);
        PG8_WAIT_V(6); PG8_BAR;
    }
    for (;;) {
        const bool has_next = S.next(ui + 1, nxt);
        const char* nA = has_next ? (const char*)g.A + (size_t)nxt.pm * tstepA : cA; const char* nB = has_next ? (const char*)g.Bt + (size_t)nxt.pn * tstep : cB;
        for (int t = 0; t < nt; t += 2) {
            const bool last = (t == nt - 2);
            const char* a1 = cA + (size_t)(t + 1) * kstep;
            const char* a2 = last ? nA : cA + (size_t)(t + 2) * kstep; const char* b2 = last ? nB : cB + (size_t)(t + 2) * kstep;
            const char* a3 = a2 + kstep; const char* b3 = b2 + kstep;
            if (last && has_next) S.a_ready(nxt);
            if constexpr (SP2) {
            PG8_LDB(B0, 0, 0); PG8_LDB(B1, 0, 1); PG8_SCHED; PG8_LDA(At, 0, 0); PG8_STAGE(PG8_SA(1, 1), a1 + hstepA, voffA);
            PG8_WAIT_V(8); PG8_WAIT_L(0); PG8_BAR; PG8_MMA(0, 0, At, B0); PG8_MMA(0, 1, At, B1); PG8_BAR; PG8_SCHED;
            PG8_LDA(At, 0, 1); PG8_STAGE(PG8_SB(0, 0), b2, voffB); PG8_STAGE(PG8_SB(0, 1), b2 + hstep, voffB); PG8_STAGE(PG8_SA(0, 0), a2, voffA);
            PG8_WAIT_V(8); PG8_WAIT_L(0); PG8_BAR; PG8_MMA(1, 0, At, B0); PG8_MMA(1, 1, At, B1); PG8_BAR; PG8_SCHED;
            PG8_LDB(B0, 1, 0); PG8_LDB(B1, 1, 1); PG8_SCHED; PG8_LDA(At, 1, 0); PG8_STAGE(PG8_SA(0, 1), a2 + hstepA, voffA);
            PG8_WAIT_V(8); PG8_WAIT_L(0); PG8_BAR; PG8_MMA(0, 0, At, B0); PG8_MMA(0, 1, At, B1); PG8_BAR; PG8_SCHED;
            PG8_LDA(At, 1, 1); PG8_STAGE(PG8_SB(1, 0), b3, voffB); PG8_STAGE(PG8_SB(1, 1), b3 + hstep, voffB); PG8_STAGE(PG8_SA(1, 0), a3, voffA);
            PG8_WAIT_V(8); PG8_WAIT_L(0); PG8_BAR; PG8_MMA(1, 0, At, B0); PG8_MMA(1, 1, At, B1); PG8_BAR; PG8_SCHED;
            } else {
            PG8_LDB(B0, 0, 0); PG8_SCHED; PG8_LDA(At, 0, 0); PG8_STAGE(PG8_SA(1, 1), a1 + hstepA, voffA);
            PG8_WAIT_L(8); PG8_BAR; PG8_WAIT_L(0); PG8_MMA(0, 0, At, B0); PG8_BAR; PG8_SCHED;
            PG8_LDB(B1, 0, 1); PG8_STAGE(PG8_SB(0, 0), b2, voffB);
            PG8_BAR; PG8_WAIT_L(0); PG8_MMA(0, 1, At, B1); PG8_BAR;
            PG8_LDA(At, 0, 1); PG8_STAGE(PG8_SA(0, 0), a2, voffA);
            PG8_BAR; PG8_WAIT_L(0); PG8_MMA(1, 0, At, B0); PG8_BAR; PG8_SCHED;
            PG8_STAGE(PG8_SB(0, 1), b2 + hstep, voffB);
            PG8_WAIT_V(6); PG8_BAR; PG8_MMA(1, 1, At, B1); PG8_BAR;
            PG8_LDB(B0, 1, 0); PG8_SCHED; PG8_LDA(At, 1, 0); PG8_STAGE(PG8_SA(0, 1), a2 + hstepA, voffA);
            PG8_WAIT_L(8); PG8_BAR; PG8_WAIT_L(0); PG8_MMA(0, 0, At, B0); PG8_BAR; PG8_SCHED;
            PG8_LDB(B1, 1, 1); PG8_STAGE(PG8_SB(1, 0), b3, voffB);
            PG8_BAR; PG8_WAIT_L(0); PG8_MMA(0, 1, At, B1); PG8_BAR;
            PG8_LDA(At, 1, 1); PG8_STAGE(PG8_SA(1, 0), a3, voffA);
            PG8_BAR; PG8_WAIT_L(0); PG8_MMA(1, 0, At, B0); PG8_BAR; PG8_SCHED;
            PG8_STAGE(PG8_SB(1, 1), b3 + hstep, voffB);
            PG8_WAIT_V(6); PG8_BAR; PG8_MMA(1, 1, At, B1); PG8_BAR;
            }
        }
        if constexpr (ALIGN_EPI) { if (wr == 0) PG8_BAR; }
        if constexpr (!Epi::AFTER_DRAIN) { E(acc, cur, wr, wc, fr, fq); S.done(cur); PG8_WAIT_V(0);   }
        if (!has_next) break;
#pragma unroll
        for (int a = 0; a < 2; ++a)
#pragma unroll
            for (int b = 0; b < 2; ++b)
#pragma unroll
                for (int m = 0; m < 4; ++m)
#pragma unroll
                    for (int n = 0; n < 2; ++n) acc[a][b][m][n] = (f32x4){0.f, 0.f, 0.f, 0.f};
        cur = nxt; cA = nA; cB = nB; ++ui;
        if constexpr (ALIGN_EPI) { if (wr == 1) PG8_BAR; }
    }
    PG8_WAIT_V(0);
    if constexpr (!ALIGN_EPI) { if (wr == 0) PG8_BAR; }
    PG8_BAR;
    if constexpr (Epi::AFTER_DRAIN) { E.fused(acc, cur, wr, wc, fr, fq, lds, wid, lane); S.done(cur); }
#undef PG8_SA
#undef PG8_SB
#undef PG8_STAGE
#undef PG8_LDA
#undef PG8_LDB
#undef PG8_MMA
#undef PG8_WAIT_V
#undef PG8_WAIT_L
#undef PG8_BAR
#undef PG8_SCHED
}
}
#define GAS __attribute__((address_space(1)))
#define LAS __attribute__((address_space(3)))
typedef unsigned short bf16;
typedef unsigned v4u __attribute__((ext_vector_type(4)));
typedef float f32x4 __attribute__((ext_vector_type(4)));
typedef short bf16x8 __attribute__((ext_vector_type(8)));
typedef GAS unsigned gu32;
typedef GAS unsigned long long gu64;
#define RLX_AGENT __ATOMIC_RELAXED, __HIP_MEMORY_SCOPE_AGENT
#define LDS_WAIT() asm volatile("s_waitcnt lgkmcnt(0)" ::: "memory")
#define VM_WAIT() asm volatile("s_waitcnt vmcnt(0)" ::: "memory")
__device__ __forceinline__ unsigned long long rt() { return __builtin_amdgcn_s_memrealtime(); }
__device__ __forceinline__ unsigned f2bf(float f) { unsigned u = __builtin_bit_cast(unsigned, f); return (u + 0x7fffu + ((u >> 16) & 1u)) >> 16; }
__device__ __forceinline__ unsigned pk2(float lo, float hi) { return f2bf(lo) | (f2bf(hi) << 16); }
#define XB_TMO      128
#define XB_XCNT(j)  (256  + 64 * (j))
#define XB_XSUB(j)  (1280 + 64 * (j))
#define XB_XGEN(j)  (2304 + 64 * (j))
#define XB_TOP      3328
#define XB_TOPGEN   3392
#define XCD_BAR_WORDS 3456
#define XB_SPIN_CAP (1u << 18)

__device__ __forceinline__ unsigned xb_ld(unsigned* p)              { return __hip_atomic_load(p, __ATOMIC_RELAXED, __HIP_MEMORY_SCOPE_AGENT); }
__device__ __forceinline__ unsigned xb_add(unsigned* p, unsigned v) { return __hip_atomic_fetch_add(p, v, __ATOMIC_RELAXED, __HIP_MEMORY_SCOPE_AGENT); }
__device__ __forceinline__ unsigned xb_xcc_id() { return (unsigned)__builtin_amdgcn_s_getreg((3 << 11) | 20) & 0xFu; }
#define XB_SPIN(cond, bar) do { unsigned _sp = 0; while (cond) { __builtin_amdgcn_s_sleep(1); \
    if ((++_sp & 255u) == 0u) { if (xb_ld(&(bar)[XB_TMO])) break; if (_sp > XB_SPIN_CAP) { atomicAdd(&(bar)[XB_TMO], 1u); break; } } } } while (0)

struct XcdBarrier {
    unsigned* bar; unsigned x;
    volatile LAS unsigned* st;
};

__device__ __forceinline__ XcdBarrier xcd_barrier_post(unsigned* bar, volatile LAS unsigned* st) {
    XcdBarrier b; b.bar = bar; b.x = xb_xcc_id(); b.st = st;
    if (threadIdx.x == 0) (void)xb_add(&bar[XB_XCNT(b.x)], 1u);
    return b;
}
__device__ __forceinline__ void xcd_barrier_complete(unsigned* bar, unsigned x, unsigned& nloc, unsigned& nx) {
    const unsigned G = gridDim.x * gridDim.y * gridDim.z;
    unsigned sum, cnt, mine, sp = 0u;
    for (;;) {
        sum = 0u; cnt = 0u; mine = 0u;
#pragma unroll
        for (unsigned j = 0; j < 16; ++j) { const unsigned c = xb_ld(&bar[XB_XCNT(j)]); sum += c; cnt += (c > 0u) ? 1u : 0u; mine = (j == x) ? c : mine; }
        if (sum == G) break;
        __builtin_amdgcn_s_sleep(1);
        if ((++sp & 255u) == 0u) { if (xb_ld(&bar[XB_TMO])) break; if (sp > XB_SPIN_CAP) { atomicAdd(&bar[XB_TMO], 1u); break; } }
    }
    nloc = mine > 0u ? mine : 1u; nx = cnt > 0u ? cnt : 1u;
}

__device__ __forceinline__ void xcd_barrier(const XcdBarrier& b, const int wave_id) {
    asm volatile("s_waitcnt vmcnt(0)" ::: "memory");
    __syncthreads();
    int lane_; asm volatile("v_mbcnt_lo_u32_b32 %0, -1, 0\n\tv_mbcnt_hi_u32_b32 %0, -1, %0" : "=v"(lane_));
    if (wave_id == 0 && lane_ == 0) {
        unsigned* bar = b.bar;
        __builtin_amdgcn_s_waitcnt(0);
        unsigned nloc = b.st[0], nx = b.st[1];
        if (nloc == 0u) { xcd_barrier_complete(bar, b.x, nloc, nx); b.st[0] = nloc; b.st[1] = nx; }
        const unsigned old = xb_add(&bar[XB_XSUB(b.x)], 1u);
        const unsigned gen = old / nloc;
        if (old + 1u == (gen + 1u) * nloc) {
            __builtin_amdgcn_fence(__ATOMIC_RELEASE, "agent");
            asm volatile("s_waitcnt vmcnt(0)" ::: "memory");
            const unsigned og = xb_add(&bar[XB_TOP], 1u);
            const unsigned tg = og / nx;
            if (og + 1u == (tg + 1u) * nx) xb_add(&bar[XB_TOPGEN], 1u);
            else XB_SPIN(xb_ld(&bar[XB_TOPGEN]) == tg, bar);
            __builtin_amdgcn_fence(__ATOMIC_ACQUIRE, "agent");
            xb_add(&bar[XB_XGEN(b.x)], 1u);
            asm volatile("s_waitcnt vmcnt(0)" ::: "memory");
        } else {
            XB_SPIN(xb_ld(&bar[XB_XGEN(b.x)]) == gen, bar);
            __builtin_amdgcn_fence(__ATOMIC_ACQUIRE, "agent");
            asm volatile("s_waitcnt vmcnt(0)" ::: "memory");
        }
    }
    __syncthreads();
}
constexpr int NWAVES = 8;
constexpr int DM = 1024, BATCH = 16, SEQ = 2048, DEPTH = 2, M = BATCH * SEQ, DFF = 2816, INC = 4888;
constexpr int N13 = 2 * DFF, NIN = 5120, NUP = 2048;
constexpr float LOG2E = 1.4426950408889634f;
constexpr float C2 = 0.125f * LOG2E;
constexpr size_t MiB = 1u << 20;
constexpr size_t WS_CTL = 0, CTL_ZERO_BYTES = 2 * MiB;
constexpr size_t WS_KMS = 1 * MiB;
constexpr size_t WS_W13 = 2 * MiB;
constexpr size_t WS_W2 = 46 * MiB;
constexpr size_t WS_WIN = 68 * MiB;
constexpr size_t WS_WUP = 88 * MiB;
constexpr size_t WS_WOUT = 96 * MiB;
constexpr size_t WS_WC1 = 100 * MiB;
constexpr size_t WS_WC2 = 104 * MiB;
constexpr size_t WS_BC1 = 104 * MiB + 512 * 1024;
constexpr size_t WS_SSQ = 105 * MiB;
constexpr size_t WS_GN = 107 * MiB;
constexpr size_t WS_HID = 110 * MiB;
constexpr size_t WS_CMP = 114 * MiB;
constexpr size_t WS_XB = 116 * MiB;
constexpr size_t WS_U = 180 * MiB;
constexpr size_t WS_QN = 180 * MiB, WS_QM = 212 * MiB, WS_KVH = 244 * MiB;
constexpr size_t WS_Y = 180 * MiB;
constexpr size_t WS_SGN = 356 * MiB, WS_SGM = 420 * MiB;
constexpr size_t WS_END = 484 * MiB;
constexpr int CW_TMO = 0, CW_CODE = 1, CW_BAR = 4096;
constexpr int RING_OFF = 0, RING_BYTES = 131072;
constexpr int LDSCTL_OFF = RING_BYTES, MISC_OFF = LDSCTL_OFF + 320;
constexpr int LDS_BYTES = 147456;

using pg8::Unit; using pg8::BM; using pg8::HALF;
typedef unsigned u32x4 __attribute__((ext_vector_type(4)));

__device__ __forceinline__ float bf_lo(unsigned u) { return __uint_as_float(u << 16); }
__device__ __forceinline__ float bf_hi(unsigned u) { return __uint_as_float(u & 0xffff0000u); }
__device__ __forceinline__ float fsigmoid(float v) { return __builtin_amdgcn_rcpf(1.0f + __builtin_amdgcn_exp2f(-LOG2E * v)); }
__device__ __forceinline__ u32x4 pack8(f32x4 a, f32x4 b) { u32x4 w; w.x = pg8::cvt_pk_bf16(a[0], a[1]); w.y = pg8::cvt_pk_bf16(a[2], a[3]); w.z = pg8::cvt_pk_bf16(b[0], b[1]); w.w = pg8::cvt_pk_bf16(b[2], b[3]); return w; }
__device__ __forceinline__ float rinv_row(const float* ssq, int row) {
    const f32x4* p = (const f32x4*)(ssq + (size_t)row * 16);
    const f32x4 a = p[0], b = p[1], c = p[2], d = p[3];
    const float s = (((a[0] + a[1]) + (a[2] + a[3])) + ((b[0] + b[1]) + (b[2] + b[3]))) + (((c[0] + c[1]) + (c[2] + c[3])) + ((d[0] + d[1]) + (d[2] + d[3])));
    return 1.0f / sqrtf(s * (1.0f / 1024.0f) + 1e-6f);
}
__device__ __forceinline__ float dot4(f32x4 a) { return (a[0] * a[0] + a[1] * a[1]) + (a[2] * a[2] + a[3] * a[3]); }

struct EpiSwiGLU {
    static constexpr bool PERM = true, AFTER_DRAIN = false;
    bf16* U; const float* ssq;
    __device__ __forceinline__ void operator()(const f32x4 (&acc)[2][2][4][2], const Unit& u, int wr, int wc, int fr, int fq) const {
        const int row0 = u.pm * BM + wr * 64 + fr, col0 = u.pn * 128 + wc * 32 + 8 * fq;
#pragma unroll
        for (int ai = 0; ai < 2; ++ai)
#pragma unroll
            for (int m = 0; m < 4; ++m) { const int row = row0 + ai * HALF + m * 16; const float r = rinv_row(ssq, row);
                f32x4 h[2];
#pragma unroll
                for (int n = 0; n < 2; ++n) { const f32x4 g = acc[ai][0][m][n] * r, v = acc[ai][1][m][n] * r;
#pragma unroll
                    for (int i = 0; i < 4; ++i) h[n][i] = g[i] * fsigmoid(g[i]) * v[i]; }
                *(u32x4*)(U + (size_t)row * DFF + col0) = pack8(h[0], h[1]);
                if (m & 1) asm volatile("" ::: "memory"); }
    }
};
struct EpiResid {
    static constexpr bool PERM = true, AFTER_DRAIN = false;
    const float* xsrc; float* xdst; bf16* xb; float* ssq; float coef;
    __device__ __forceinline__ void operator()(const f32x4 (&acc)[2][2][4][2], const Unit& u, int wr, int wc, int fr, int fq) const {
        const int row0 = u.pm * BM + wr * 64 + fr, col0 = u.pn * BM + wc * 32 + 8 * fq;
#pragma unroll
        for (int ai = 0; ai < 2; ++ai)
#pragma unroll
            for (int m = 0; m < 4; ++m) { const int row = row0 + ai * HALF + m * 16; float sq = 0.f;
#pragma unroll
                for (int bj = 0; bj < 2; ++bj) { const size_t off = (size_t)row * DM + col0 + bj * HALF;
                    const f32x4 x0 = *(const f32x4*)(xsrc + off), x1 = *(const f32x4*)(xsrc + off + 4);
                    const f32x4 y0 = x0 + acc[ai][bj][m][0] * coef, y1 = x1 + acc[ai][bj][m][1] * coef;
                    *(f32x4*)(xdst + off) = y0; *(f32x4*)(xdst + off + 4) = y1;
                    *(u32x4*)(xb + off) = pack8(y0, y1);
                    sq += dot4(y0) + dot4(y1); }
                sq += __shfl_xor(sq, 16); sq += __shfl_xor(sq, 32);
                if (fq == 0) ssq[(size_t)row * 16 + u.pn * 4 + wc] = sq;
                if (m & 1) asm volatile("" ::: "memory"); }
    }
};
struct EpiUp {
    static constexpr bool PERM = true, AFTER_DRAIN = false;
    bf16* Y; const bf16* sgn; const bf16* sgm;
    __device__ __forceinline__ void operator()(const f32x4 (&acc)[2][2][4][2], const Unit& u, int wr, int wc, int fr, int fq) const {
        const int row0 = u.pm * BM + wr * 64 + fr, col0 = u.pn * 128 + wc * 32 + 8 * fq;
#pragma unroll
        for (int ai = 0; ai < 2; ++ai)
#pragma unroll
            for (int m = 0; m < 4; ++m) { const int row = row0 + ai * HALF + m * 16; const size_t off = (size_t)row * DM + col0;
                const u32x4 a = *(const u32x4*)(sgn + off), b = *(const u32x4*)(sgm + off);
                f32x4 y0, y1;
                y0[0] = bf_lo(a.x) * acc[ai][0][m][0][0] + bf_lo(b.x) * acc[ai][1][m][0][0]; y0[1] = bf_hi(a.x) * acc[ai][0][m][0][1] + bf_hi(b.x) * acc[ai][1][m][0][1];
                y0[2] = bf_lo(a.y) * acc[ai][0][m][0][2] + bf_lo(b.y) * acc[ai][1][m][0][2]; y0[3] = bf_hi(a.y) * acc[ai][0][m][0][3] + bf_hi(b.y) * acc[ai][1][m][0][3];
                y1[0] = bf_lo(a.z) * acc[ai][0][m][1][0] + bf_lo(b.z) * acc[ai][1][m][1][0]; y1[1] = bf_hi(a.z) * acc[ai][0][m][1][1] + bf_hi(b.z) * acc[ai][1][m][1][1];
                y1[2] = bf_lo(a.w) * acc[ai][0][m][1][2] + bf_lo(b.w) * acc[ai][1][m][1][2]; y1[3] = bf_hi(a.w) * acc[ai][0][m][1][3] + bf_hi(b.w) * acc[ai][1][m][1][3];
                *(u32x4*)(Y + off) = pack8(y0, y1);
                if (m & 1) asm volatile("" ::: "memory"); }
    }
};
struct EpiCmp1 {
    static constexpr bool PERM = true, AFTER_DRAIN = false;
    bf16* hid; const float* bias;
    __device__ __forceinline__ void operator()(const f32x4 (&acc)[2][2][4][2], const Unit& u, int wr, int wc, int fr, int fq) const {
        const int row0 = u.pm * BM + wr * 64 + fr, col0 = wc * 32 + 8 * fq;
#pragma unroll
        for (int ai = 0; ai < 2; ++ai)
#pragma unroll
            for (int m = 0; m < 4; ++m) { const int row = row0 + ai * HALF + m * 16;
#pragma unroll
                for (int bj = 0; bj < 2; ++bj) { f32x4 h[2];
#pragma unroll
                    for (int n = 0; n < 2; ++n) { const f32x4 v = acc[ai][bj][m][n] + *(const f32x4*)(bias + col0 + bj * HALF + 4 * n);
#pragma unroll
                        for (int i = 0; i < 4; ++i) { const float x = v[i]; h[n][i] = x * fsigmoid(1.5957691216f * (x + 0.044715f * x * x * x)); } }
                    *(u32x4*)(hid + (size_t)row * 256 + col0 + bj * HALF) = pack8(h[0], h[1]); }
                asm volatile("" ::: "memory"); }
    }
};
struct EpiCmp2 {
    static constexpr bool PERM = true, AFTER_DRAIN = false;
    bf16* dst; const float* g;
    __device__ __forceinline__ void operator()(const f32x4 (&acc)[2][2][4][2], const Unit& u, int wr, int wc, int fr, int fq) const {
        if (wc != 0) return;
        const int row0 = u.pm * BM + wr * 64 + fr;
#pragma unroll
        for (int ai = 0; ai < 2; ++ai)
#pragma unroll
            for (int m = 0; m < 4; ++m) { const int row = row0 + ai * HALF + m * 16;
                float ss = 0.f;
#pragma unroll
                for (int bj = 0; bj < 2; ++bj)
#pragma unroll
                    for (int n = 0; n < 2; ++n) ss += dot4(acc[ai][bj][m][n]);
                float hr = 1.0f;
                if (g) { ss += __shfl_xor(ss, 16); ss += __shfl_xor(ss, 32); hr = 1.0f / sqrtf(ss * (1.0f / 64.0f) + 1e-6f); }
#pragma unroll
                for (int bj = 0; bj < 2; ++bj) { f32x4 v[2];
#pragma unroll
                    for (int n = 0; n < 2; ++n) { const f32x4 gvv = g ? *(const f32x4*)(g + 32 * bj + 8 * fq + 4 * n) : (f32x4){1.f, 1.f, 1.f, 1.f}; v[n] = acc[ai][bj][m][n] * hr * gvv; }
                    *(u32x4*)(dst + (size_t)row * 64 + 32 * bj + 8 * fq) = pack8(v[0], v[1]); }
                asm volatile("" ::: "memory"); }
    }
};
struct EpiWin {
    static constexpr bool PERM = true, AFTER_DRAIN = false;
    const float* ssq; bf16* Qn; bf16* Qm; bf16* KVH; bf16* SGN; bf16* SGM; float* GN; float* KMS; const float* gqn; const float* gqm;
    __device__ __forceinline__ void operator()(const f32x4 (&acc)[2][2][4][2], const Unit& u, int wr, int wc, int fr, int fq) const {
        const int pn = u.pn, row0 = u.pm * BM + wr * 64 + fr;
        if (pn >= 11 && pn <= 18) {
            bf16* dst = pn < 15 ? SGN : SGM; const int col0 = 256 * ((pn - 11) & 3) + wc * 32 + 8 * fq;
#pragma unroll
            for (int ai = 0; ai < 2; ++ai)
#pragma unroll
                for (int m = 0; m < 4; ++m) { const int row = row0 + ai * HALF + m * 16; const float r = rinv_row(ssq, row);
#pragma unroll
                    for (int bj = 0; bj < 2; ++bj) { f32x4 s[2];
#pragma unroll
                        for (int n = 0; n < 2; ++n)
#pragma unroll
                            for (int i = 0; i < 4; ++i) s[n][i] = fsigmoid(acc[ai][bj][m][n][i] * r);
                        *(u32x4*)(dst + (size_t)row * DM + col0 + bj * HALF) = pack8(s[0], s[1]); }
                    if (m & 1) asm volatile("" ::: "memory"); }
            return;
        }
        if (pn == 19) {
            if (wc == 0 && fq < 3) {
#pragma unroll
                for (int ai = 0; ai < 2; ++ai)
#pragma unroll
                    for (int m = 0; m < 4; ++m) { const int row = row0 + ai * HALF + m * 16; const float r = rinv_row(ssq, row);
#pragma unroll
                        for (int n = 0; n < 2; ++n) { f32x4 s;
#pragma unroll
                            for (int i = 0; i < 4; ++i) s[i] = fsigmoid(acc[ai][0][m][n][i] * r);
                            *(f32x4*)(GN + (size_t)row * 24 + 8 * fq + 4 * n) = s; } }
            }
            return;
        }
        const bool isq = (pn <= 1) || pn == 5 || pn == 6;
        bf16* base; size_t rstride; const float* g = nullptr; bool kmean = false; float oscale = 1.0f; int hm = 0;
        if (isq) { const int head = (pn <= 1 ? 4 * pn : 4 * (pn - 5)) + wc; base = (pn <= 1 ? Qn : Qm) + 64 * head; rstride = 512; g = pn <= 1 ? gqn : gqm; oscale = C2; }
        else { int slot;
            if (pn == 2) slot = wc; else if (pn == 3) { slot = 4 + wc; g = gqn + 64 * (2 + (wc >> 1)); } else if (pn == 4) slot = 8 + wc;
            else if (pn <= 8) { hm = 4 * (pn - 7) + wc; slot = 12 + hm; g = gqm + 64; kmean = true; } else slot = 20 + 4 * (pn - 9) + wc;
            base = KVH + (size_t)slot * M * 64; rstride = 64; }
        f32x4 gv[2][2], ks[2][2];
#pragma unroll
        for (int bj = 0; bj < 2; ++bj)
#pragma unroll
            for (int n = 0; n < 2; ++n) { gv[bj][n] = g ? *(const f32x4*)(g + 32 * bj + 8 * fq + 4 * n) : (f32x4){1.f, 1.f, 1.f, 1.f}; ks[bj][n] = (f32x4){0.f, 0.f, 0.f, 0.f}; }
#pragma unroll
        for (int ai = 0; ai < 2; ++ai)
#pragma unroll
            for (int m = 0; m < 4; ++m) { const int row = row0 + ai * HALF + m * 16; const float r = rinv_row(ssq, row);
                f32x4 v[2][2]; float ss = 0.f;
#pragma unroll
                for (int bj = 0; bj < 2; ++bj)
#pragma unroll
                    for (int n = 0; n < 2; ++n) { v[bj][n] = acc[ai][bj][m][n] * r; ss += dot4(v[bj][n]); }
                if (g) { ss += __shfl_xor(ss, 16); ss += __shfl_xor(ss, 32); const float hr = oscale / sqrtf(ss * (1.0f / 64.0f) + 1e-6f);
#pragma unroll
                    for (int bj = 0; bj < 2; ++bj)
#pragma unroll
                        for (int n = 0; n < 2; ++n) v[bj][n] = v[bj][n] * hr * gv[bj][n]; }
                if (kmean) {
#pragma unroll
                    for (int bj = 0; bj < 2; ++bj)
#pragma unroll
                        for (int n = 0; n < 2; ++n) ks[bj][n] += v[bj][n]; }
#pragma unroll
                for (int bj = 0; bj < 2; ++bj) *(u32x4*)(base + (size_t)row * rstride + 32 * bj + 8 * fq) = pack8(v[bj][0], v[bj][1]);
                if (m & 1) asm volatile("" ::: "memory"); }
        if (kmean) {
            const int b = u.pm >> 3, nb = u.pm & 7; float* kd = KMS + (((size_t)b * 8 + hm) * 8 + nb) * 64;
#pragma unroll
            for (int bj = 0; bj < 2; ++bj)
#pragma unroll
                for (int n = 0; n < 2; ++n)
#pragma unroll
                    for (int i = 0; i < 4; ++i) { float s = ks[bj][n][i]; s += __shfl_xor(s, 1); s += __shfl_xor(s, 2); s += __shfl_xor(s, 4); s += __shfl_xor(s, 8);
                        if (fr == 0) atomicAdd(kd + 32 * bj + 8 * fq + 4 * n + i, s); }
        }
    }
};

struct Args { const float* in[14]; float* out; unsigned char* ws; int ph_lo, ph_hi, seq, prev_blocks; };
struct Frame {
    LAS unsigned char* lds; volatile LAS unsigned* MISC; gu32* ctl;
    int tid, lane, wave, vcu, G;
};


constexpr int CW_DONE = 8192;
__device__ __forceinline__ void launch_wait(gu32* ctl, int seq, int prev_blocks) {
    if (threadIdx.x == 0 && prev_blocks > 0) {
        unsigned sp = 0;
        while (__hip_atomic_load(ctl + CW_DONE + 64 * (seq - 1), __ATOMIC_RELAXED, __HIP_MEMORY_SCOPE_AGENT) < (unsigned)prev_blocks) { __builtin_amdgcn_s_sleep(2); if (++sp > (1u << 26)) break; }
        __builtin_amdgcn_fence(__ATOMIC_ACQUIRE, "agent"); asm volatile("s_waitcnt vmcnt(0)" ::: "memory");
    }
    __syncthreads();
}
__device__ __forceinline__ void launch_done(gu32* ctl, int seq) {
    asm volatile("s_waitcnt vmcnt(0)" ::: "memory"); __syncthreads();
    if (threadIdx.x == 0) { __builtin_amdgcn_fence(__ATOMIC_RELEASE, "agent"); asm volatile("s_waitcnt vmcnt(0)" ::: "memory");
        __hip_atomic_fetch_add(ctl + CW_DONE + 64 * seq, 1u, __ATOMIC_RELAXED, __HIP_MEMORY_SCOPE_AGENT); }
}
enum { MAP_ID = 0, MAP_GU = 1, MAP_HEAD = 2 };
struct Job { int src, soff, K, N, n0, nc, gsrc, goff, doff_kb  , Kd, kofs, map, mp; };
constexpr int NJOBS = 52;
struct JobTable { Job j[NJOBS]; int first[NJOBS + 1]; };
constexpr JobTable build_jobs() {
    JobTable T{}; int n = 0;
    for (int l = 0; l < 2; ++l) {
        for (int f = 0; f < 2; ++f) {
            const int nf = f == 0 ? 0 : 2, lf = l * 2 + f;
            T.j[n++] = Job{2, lf * DM * DFF, DM, DFF, 0, DFF, 1, (l * 3 + nf) * DM, (int)((WS_W13 + (size_t)lf * N13 * DM * 2) >> 10), DM, 0, MAP_GU, 0};
            T.j[n++] = Job{3, lf * DM * DFF, DM, DFF, 0, DFF, 1, (l * 3 + nf) * DM, (int)((WS_W13 + (size_t)lf * N13 * DM * 2) >> 10), DM, 0, MAP_GU, 128};
            T.j[n++] = Job{4, lf * DFF * DM, DFF, DM, 0, DM, -1, 0, (int)((WS_W2 + (size_t)lf * DM * DFF * 2) >> 10), DFF, 0, MAP_ID, 0};
        }
        const int so = l * DM * INC, go = (l * 3 + 1) * DM, dk = (int)((WS_WIN + (size_t)l * NIN * DM * 2) >> 10);
        T.j[n++] = Job{5, so, DM, INC, 0, 512, 1, go, dk, DM, 0, MAP_HEAD, 0};
        T.j[n++] = Job{5, so, DM, INC, 512, 128, 1, go, dk, DM, 0, MAP_HEAD, 8};
        T.j[n++] = Job{5, so, DM, INC, 640, 128, 1, go, dk, DM, 0, MAP_HEAD, 10};
        T.j[n++] = Job{5, so, DM, INC, 768, 128, 1, go, dk, DM, 0, MAP_HEAD, 12};
        T.j[n++] = Job{5, so, DM, INC, 896, 128, 1, go, dk, DM, 0, MAP_HEAD, 16};
        T.j[n++] = Job{5, so, DM, INC, 1024, 128, 1, go, dk, DM, 0, MAP_HEAD, 14};
        T.j[n++] = Job{5, so, DM, INC, 1152, 128, 1, go, dk, DM, 0, MAP_HEAD, 18};
        T.j[n++] = Job{5, so, DM, INC, 1280, 24, 1, go, dk, DM, 0, MAP_ID, 256 * 19};
        T.j[n++] = Job{5, so, DM, INC, 1304, 512, 1, go, dk, DM, 0, MAP_HEAD, 20};
        T.j[n++] = Job{5, so, DM, INC, 1816, 512, 1, go, dk, DM, 0, MAP_HEAD, 28};
        T.j[n++] = Job{5, so, DM, INC, 2328, 512, 1, go, dk, DM, 0, MAP_HEAD, 36};
        T.j[n++] = Job{5, so, DM, INC, 2840, 1024, 1, go, dk, DM, 0, MAP_ID, 256 * 11};
        T.j[n++] = Job{5, so, DM, INC, 3864, 1024, 1, go, dk, DM, 0, MAP_ID, 256 * 15};
        const int du = (int)((WS_WUP + (size_t)l * NUP * DM * 2) >> 10);
        T.j[n++] = Job{11, l * 512 * DM, 512, DM, 0, DM, -1, 0, du, DM, 0, MAP_GU, 0};
        T.j[n++] = Job{12, l * 512 * DM, 512, DM, 0, DM, -1, 0, du, DM, 512, MAP_GU, 128};
        T.j[n++] = Job{13, l * DM * DM, DM, DM, 0, DM, -1, 0, (int)((WS_WOUT + (size_t)l * DM * DM * 2) >> 10), DM, 0, MAP_ID, 0};
        for (int kv = 0; kv < 2; ++kv) {
            const int lk = l * 2 + kv;
            T.j[n++] = Job{9, lk * 2048 * 256, 2048, 256, 0, 256, -1, 0, (int)((WS_WC1 + (size_t)lk * 256 * 2048 * 2) >> 10), 2048, 0, MAP_ID, 0};
            T.j[n++] = Job{10, lk * 256 * 64, 256, 64, 0, 64, -1, 0, (int)((WS_WC2 + (size_t)lk * 256 * 256 * 2) >> 10), 256, 0, MAP_HEAD, 0};
        }
    }
    int tot = 0;
    for (int i = 0; i < NJOBS; ++i) { T.first[i] = tot; tot += (T.j[i].K / 64) * ((T.j[i].nc + 31) / 32); }
    T.first[NJOBS] = tot;
    return T;
}
__device__ const JobTable JT = build_jobs();
__device__ __forceinline__ int map_row(int map, int mp, int x) {
    if (map == MAP_ID) return mp + x;
    if (map == MAP_GU) return 256 * (x >> 7) + (x & 127) + mp;
    const int hs = mp + (x >> 6), d = x & 63; return 256 * (hs >> 2) + 128 * (d >> 5) + 32 * (hs & 3) + (d & 31);
}
__device__ __forceinline__ void tr_item(const float* W, int N, int k0, int nsrc0, int ncv, const float* gain, bf16* dst, int Kd, int kofs, int map, int mp, int x0, LAS float* scr, int lane) {
    const int c = lane & 31;
#pragma unroll 8
    for (int i = 0; i < 32; ++i) { const int kk = 2 * i + (lane >> 5); float v = (c < ncv) ? W[(size_t)(k0 + kk) * N + nsrc0 + c] : 0.f; if (gain) v *= gain[k0 + kk]; scr[kk * 33 + c] = v; }
    LDS_WAIT(); asm volatile("" ::: "memory");
    const int c8 = lane & 7;
#pragma unroll
    for (int j = 0; j < 4; ++j) { const int n = (lane >> 3) + 8 * j; const LAS float* s = scr + (8 * c8) * 33 + n;
        v4u o; o.x = pk2(s[0 * 33], s[1 * 33]); o.y = pk2(s[2 * 33], s[3 * 33]); o.z = pk2(s[4 * 33], s[5 * 33]); o.w = pk2(s[6 * 33], s[7 * 33]);
        if (n < ncv) *(GAS v4u*)(dst + (size_t)map_row(map, mp, x0 + n) * Kd + kofs + k0 + 8 * c8) = o; }
    LDS_WAIT(); asm volatile("" ::: "memory");
}
__device__ __forceinline__ const float* in_ptr(const Args& a, int i) {
    const float* p = a.in[0];
    p = i == 1 ? a.in[1] : p; p = i == 2 ? a.in[2] : p; p = i == 3 ? a.in[3] : p; p = i == 4 ? a.in[4] : p; p = i == 5 ? a.in[5] : p; p = i == 9 ? a.in[9] : p;
    p = i == 10 ? a.in[10] : p; p = i == 11 ? a.in[11] : p; p = i == 12 ? a.in[12] : p; p = i == 13 ? a.in[13] : p; return p;
}
__device__ __forceinline__ float wave_sum(float v) {
#pragma unroll
    for (int o = 1; o < 64; o <<= 1) v += __shfl_xor(v, o);
    return v;
}
__device__ __forceinline__ void p0_prologue(Frame& F, const Args& a) {
    LAS float* scr = (LAS float*)(F.lds + RING_OFF + F.wave * 16384);
    const int gw = F.vcu * NWAVES + F.wave, NGW = F.G * NWAVES;
    unsigned char* ws = a.ws;
    const int total = JT.first[NJOBS];
    for (int it = gw; it < total; it += NGW) {
        int ji = 0;
        for (int q = 1; q < NJOBS; ++q) ji = (it >= JT.first[q]) ? q : ji;
        const Job jb = JT.j[ji]; const int r = it - JT.first[ji];
        const int nblk = (jb.nc + 31) >> 5, kb = r / nblk, nb = r % nblk;
        const int ncv = (jb.nc - 32 * nb) < 32 ? (jb.nc - 32 * nb) : 32;
        tr_item(in_ptr(a, jb.src) + jb.soff, jb.N, 64 * kb, jb.n0 + 32 * nb, ncv, jb.gsrc >= 0 ? a.in[1] + jb.goff : nullptr,
                (bf16*)(ws + ((size_t)jb.doff_kb << 10)), jb.Kd, jb.kofs, jb.map, jb.mp, 32 * nb, scr, F.lane);
    }
    const int gt = F.vcu * (NWAVES * 64) + F.tid, GT = F.G * NWAVES * 64; const v4u z = {0u, 0u, 0u, 0u};
    for (int i = gt; i < 2 * 232 * 128; i += GT) { const int l = i / (232 * 128), r = i % (232 * 128); *(GAS v4u*)(ws + WS_WIN + (size_t)l * NIN * DM * 2 + (size_t)(19 * 256 + 24 + r / 128) * 2048 + (r % 128) * 16) = z; }
    for (int i = gt; i < 2 * 2048 * 64; i += GT) { const int l = i / (2048 * 64), r = (i / 64) % 2048, c = i % 64; const int kz = ((r & 255) < 128) ? 512 : 0;
        *(GAS v4u*)(ws + WS_WUP + (size_t)l * NUP * DM * 2 + (size_t)r * 2048 + kz * 2 + c * 16) = z; }
    for (int i = gt; i < 4 * 256 * 32; i += GT) { const int lk = i / (256 * 32), r = (i / 32) % 256, c = i % 32;
        if ((r & 127) >= 32) *(GAS v4u*)(ws + WS_WC2 + (size_t)lk * 256 * 256 * 2 + (size_t)r * 512 + c * 16) = z; }
    for (int i = gt; i < 2 * 16 * 8 * 8 * 64 / 4; i += GT) *(GAS v4u*)(ws + WS_KMS + (size_t)i * 16) = z;
    { const float* x = a.in[0]; bf16* xb = (bf16*)(ws + WS_XB); float* ssq = (float*)(ws + WS_SSQ);
      for (int m = gw; m < M; m += NGW) { const GAS f32x4* xr = (const GAS f32x4*)(x + (size_t)m * DM) + F.lane; f32x4 v[4]; float s = 0.f;
#pragma unroll
          for (int j = 0; j < 4; ++j) { v[j] = xr[64 * j]; s += dot4(v[j]); }
          s = wave_sum(s);
          GAS unsigned long long* o8 = (GAS unsigned long long*)(xb + (size_t)m * DM) + F.lane;
#pragma unroll
          for (int j = 0; j < 4; ++j) o8[64 * j] = (unsigned long long)pk2(v[j][0], v[j][1]) | ((unsigned long long)pk2(v[j][2], v[j][3]) << 32);
          if (F.lane < 16) ssq[(size_t)m * 16 + F.lane] = F.lane == 0 ? s : 0.f; } }
    if (blockIdx.x < 16) {
        const int lk = blockIdx.x >> 2, cg = blockIdx.x & 3, col = cg * 64 + F.lane;
        const float* pos = a.in[8] + (size_t)lk * 2048; const float* w1 = a.in[9] + (size_t)lk * 2048 * 256;
        float s = 0.f;
        for (int k = 256 * F.wave; k < 256 * F.wave + 256; ++k) s += pos[k] * w1[(size_t)k * 256 + col];
        LAS float* red = (LAS float*)(F.lds + RING_OFF);
        __syncthreads();
        red[F.wave * 64 + F.lane] = s;
        __syncthreads();
        if (F.wave == 0) { float t = 0.f;
#pragma unroll
            for (int w = 0; w < 8; ++w) t += red[w * 64 + F.lane];
            ((float*)(ws + WS_BC1))[lk * 256 + col] = t; }
        __syncthreads();
    }
}

__device__ __forceinline__ float dot64(const unsigned (&q)[32], const bf16* p) {
    float s0 = 0.f, s1 = 0.f;
#pragma unroll
    for (int c = 0; c < 8; ++c) { const u32x4 k = *(const u32x4*)(p + 8 * c);
        s0 += bf_lo(q[4 * c]) * bf_lo(k.x); s1 += bf_hi(q[4 * c]) * bf_hi(k.x); s0 += bf_lo(q[4 * c + 1]) * bf_lo(k.y); s1 += bf_hi(q[4 * c + 1]) * bf_hi(k.y);
        s0 += bf_lo(q[4 * c + 2]) * bf_lo(k.z); s1 += bf_hi(q[4 * c + 2]) * bf_hi(k.z); s0 += bf_lo(q[4 * c + 3]) * bf_lo(k.w); s1 += bf_hi(q[4 * c + 3]) * bf_hi(k.w); }
    return s0 + s1;
}
__device__ __forceinline__ void axpy64(float (&o)[64], float p, const bf16* v) {
#pragma unroll
    for (int c = 0; c < 8; ++c) { const u32x4 k = *(const u32x4*)(v + 8 * c);
        o[8 * c + 0] += p * bf_lo(k.x); o[8 * c + 1] += p * bf_hi(k.x); o[8 * c + 2] += p * bf_lo(k.y); o[8 * c + 3] += p * bf_hi(k.y);
        o[8 * c + 4] += p * bf_lo(k.z); o[8 * c + 5] += p * bf_hi(k.z); o[8 * c + 6] += p * bf_lo(k.w); o[8 * c + 7] += p * bf_hi(k.w); }
}
__device__ __forceinline__ void loadq(unsigned (&q)[32], const bf16* p) {
#pragma unroll
    for (int c = 0; c < 8; ++c) { const u32x4 k = *(const u32x4*)(p + 8 * c); q[4 * c] = k.x; q[4 * c + 1] = k.y; q[4 * c + 2] = k.z; q[4 * c + 3] = k.w; }
}
__device__ __forceinline__ void store64(bf16* p, const float (&o)[64]) {
#pragma unroll
    for (int c = 0; c < 8; ++c) { u32x4 w; w.x = pk2(o[8 * c], o[8 * c + 1]); w.y = pk2(o[8 * c + 2], o[8 * c + 3]); w.z = pk2(o[8 * c + 4], o[8 * c + 5]); w.w = pk2(o[8 * c + 6], o[8 * c + 7]); *(u32x4*)(p + 8 * c) = w; }
}
__global__ void __launch_bounds__(256) slow_moba_kernel(Args a, int l) {
    Frame F; F.tid = threadIdx.x; F.lane = F.tid & 63; F.G = gridDim.x;
    unsigned char* ws = a.ws;
    launch_wait((gu32*)(ws + WS_CTL), a.seq, a.prev_blocks);
    const bf16* Qm = (const bf16*)(ws + WS_QM); const bf16* KVH = (const bf16*)(ws + WS_KVH); bf16* OC = (bf16*)(ws + WS_XB);
    const float* KMS = (const float*)(ws + WS_KMS) + (size_t)l * 16 * 8 * 8 * 64;
    const int GT = F.G * 256;
    for (int base = blockIdx.x * 256; base < BATCH * 8 * SEQ; base += GT) {
        const int idx = base + F.tid, t = idx & 2047, h = (idx >> 11) & 7, b = idx >> 14, row = b * SEQ + t;
        unsigned q[32]; loadq(q, Qm + (size_t)row * 512 + 64 * h);
        const int cur = t >> 8;
        const float* km = KMS + ((size_t)b * 8 + h) * 8 * 64;
        float gate[8];
#pragma unroll
        for (int n = 0; n < 8; ++n) { float s = 0.f;
#pragma unroll
            for (int c = 0; c < 32; ++c) s += bf_lo(q[c]) * km[n * 64 + 2 * c] + bf_hi(q[c]) * km[n * 64 + 2 * c + 1];
            gate[n] = s; }
        unsigned sel = 0u;
#pragma unroll
        for (int k = 0; k < 3; ++k) { float best = -3.0e38f; int bi = -1;
#pragma unroll
            for (int n = 0; n < 8; ++n) { const bool ok = (n < cur) && !((sel >> n) & 1u) && gate[n] > best; best = ok ? gate[n] : best; bi = ok ? n : bi; }
            if (bi >= 0) sel |= 1u << bi; }
        const unsigned blocks = sel | (1u << cur);
        const float sl2 = exp2f(-(float)(h + 1)) * LOG2E;
        const bf16* Kh = KVH + ((size_t)(12 + h) * M + (size_t)b * SEQ) * 64; const bf16* Vh = KVH + ((size_t)(20 + h) * M + (size_t)b * SEQ) * 64;
        float lsum = 0.f; float o[64];
#pragma unroll
        for (int d = 0; d < 64; ++d) o[d] = 0.f;
        const int thi = t | 63;
        for (int n = 0; n <= cur; ++n) {
            const bool mine = (blocks >> n) & 1u;
            if (!__any(mine)) continue;
            const int shi = (256 * n + 255) < thi ? (256 * n + 255) : thi;
            for (int s = 256 * n; s <= shi; ++s) {
                const float sc = dot64(q, Kh + (size_t)s * 64) + sl2 * (float)(s - t);
                const float p = (mine && s <= t) ? exp2f(sc) : 0.f;
                lsum += p; axpy64(o, p, Vh + (size_t)s * 64);
            }
        }
        const float il = 1.0f / lsum;
#pragma unroll
        for (int d = 0; d < 64; ++d) o[d] *= il;
        store64(OC + (size_t)row * DM + 512 + 64 * h, o);
    }
    launch_done((gu32*)(ws + WS_CTL), a.seq);
}
__global__ void __launch_bounds__(256) slow_nsa_kernel(Args a, int l) {
    __shared__ float impS[64 * 33];
    Frame F; F.tid = threadIdx.x; F.lane = F.tid & 63; F.G = gridDim.x;
    unsigned char* ws = a.ws;
    launch_wait((gu32*)(ws + WS_CTL), a.seq, a.prev_blocks);
    const bf16* Qn = (const bf16*)(ws + WS_QN); const bf16* KVH = (const bf16*)(ws + WS_KVH); bf16* OC = (bf16*)(ws + WS_XB);
    const bf16* CK = (const bf16*)(ws + WS_CMP); const bf16* CV = CK + (size_t)4096 * 64; const float* GN = (const float*)(ws + WS_GN);
    float* impL = impS;
    const int GT = F.G * 256, tok = F.tid >> 2;
    for (int base = blockIdx.x * 256; base < BATCH * 2 * SEQ * 4; base += GT) {
        const int idx = base + F.tid, r = idx & 3, t = (idx >> 2) & 2047, g = (idx >> 13) & 1, b = idx >> 14, hn = 4 * g + r, row = b * SEQ + t;
        unsigned q[32]; loadq(q, Qn + (size_t)row * 512 + 64 * hn);
        const float sl2 = exp2f(-((float)hn + 0.5f)) * LOG2E;
        const float* gp = GN + (size_t)row * 24 + hn * 3; const float g0 = gp[0], g1 = gp[1], g2 = gp[2];
        const int thi = t | 15, cur = t >> 6;
        float ot[64], ob[64];
        const bf16* Kc = CK + ((size_t)(g * 16 + b) * 128) * 64; const bf16* Vc = CV + ((size_t)(g * 16 + b) * 128) * 64;
        const int ncv = t >= 31 ? ((t - 31) >> 4) + 1 : 0, ncw = thi >= 31 ? ((thi - 31) >> 4) + 1 : 0;
        float lc = 0.f;
#pragma unroll
        for (int d = 0; d < 64; ++d) ob[d] = 0.f;
        for (int c = 0; c < ncw; ++c) {
            const float sc = dot64(q, Kc + (size_t)c * 64) + sl2 * ((float)(16 * c) + 15.5f - (float)t);
            const float p = c < ncv ? exp2f(sc) : 0.f;
            lc += p; axpy64(ob, p, Vc + (size_t)c * 64);
        }
        const float ilc = lc > 0.f ? 1.0f / lc : 0.f;
#pragma unroll
        for (int d = 0; d < 64; ++d) ot[d] = ob[d] * (g0 * ilc);
        if (r == 0) { for (int j = 0; j < 33; ++j) impL[tok * 33 + j] = 0.f; }
        for (int c = 0; c < ncw; ++c) {
            const float sc = dot64(q, Kc + (size_t)c * 64) + sl2 * ((float)(16 * c) + 15.5f - (float)t);
            float p = c < ncv ? exp2f(sc) * ilc : 0.f;
            p += __shfl_xor(p, 1); p += __shfl_xor(p, 2);
            if (r == 0) { const int j = c >> 2; if ((c & 3) == 3) { impL[tok * 33 + j] += 0.5f * p; impL[tok * 33 + j + 1] += 0.5f * p; } else impL[tok * 33 + j] += p; }
        }
        __syncthreads();
        unsigned sel = 0u;
        for (int k = 0; k < 8; ++k) { float best = -3.0e38f; int bi = 0;
            for (int j = 0; j < 32; ++j) { const float s = (j == 0 || j == cur || j == cur - 1) ? 1.0e9f : (j <= cur ? impL[tok * 33 + j] : -1.0e30f);
                const bool ok = !((sel >> j) & 1u) && s > best; best = ok ? s : best; bi = ok ? j : bi; }
            sel |= 1u << bi; }
        __syncthreads();
        { const bf16* Ks = KVH + ((size_t)(4 + g) * M + (size_t)b * SEQ) * 64; const bf16* Vs = KVH + ((size_t)(8 + g) * M + (size_t)b * SEQ) * 64;
          float ls = 0.f;
#pragma unroll
          for (int d = 0; d < 64; ++d) ob[d] = 0.f;
          for (int j = 0; j <= cur; ++j) {
              const bool mine = (sel >> j) & 1u;
              if (!__any(mine)) continue;
              const int shi = (64 * j + 63) < thi ? (64 * j + 63) : thi;
              for (int s = 64 * j; s <= shi; ++s) {
                  const float sc = dot64(q, Ks + (size_t)s * 64) + sl2 * (float)(s - t);
                  const float p = (mine && s <= t) ? exp2f(sc) : 0.f;
                  ls += p; axpy64(ob, p, Vs + (size_t)s * 64);
              }
          }
          const float w = g1 / ls;
#pragma unroll
          for (int d = 0; d < 64; ++d) ot[d] += ob[d] * w; }
        { const bf16* Kw = KVH + ((size_t)(6 + g) * M + (size_t)b * SEQ) * 64; const bf16* Vw = KVH + ((size_t)(10 + g) * M + (size_t)b * SEQ) * 64;
          float lw = 0.f;
#pragma unroll
          for (int d = 0; d < 64; ++d) ob[d] = 0.f;
          const int slo = ((t & ~15) - 511) > 0 ? ((t & ~15) - 511) : 0;
          for (int s = slo; s <= thi; ++s) {
              const int dist = t - s;
              const float sc = dot64(q, Kw + (size_t)s * 64) - sl2 * (float)dist;
              const float p = (dist >= 0 && dist < 512) ? exp2f(sc) : 0.f;
              lw += p; axpy64(ob, p, Vw + (size_t)s * 64);
          }
          const float w = g2 / lw;
#pragma unroll
          for (int d = 0; d < 64; ++d) ot[d] += ob[d] * w; }
        store64(OC + (size_t)row * DM + 64 * hn, ot);
    }
    launch_done((gu32*)(ws + WS_CTL), a.seq);
}

template <class T> __device__ __forceinline__ T* opq_ptr(T* p) { const unsigned long long v = (unsigned long long)p; unsigned lo = __builtin_amdgcn_readfirstlane((unsigned)v), hi = __builtin_amdgcn_readfirstlane((unsigned)(v >> 32)); asm volatile("" : "+s"(lo), "+s"(hi)); return (T*)(((unsigned long long)hi << 32) | lo); }
__device__ __forceinline__ int OPQ(int v) { asm volatile("" : "+s"(v)); return v; }
constexpr int N_PHASES = 19;
#ifndef RUN_PHASES
#define RUN_PHASES N_PHASES
#endif
#ifndef PHMASK
#define PHMASK 0x3ff
#endif
#define EN(k) (((PHMASK) >> (k)) & 1)
#ifndef MK_ONE_LAUNCH
#define MK_ONE_LAUNCH 0
#endif
__global__ void __launch_bounds__(NWAVES * 64, 2) fwd_kernel(Args args) {
    extern __shared__ __attribute__((aligned(16))) unsigned char lds[];
    Frame F;
    F.lds = (LAS unsigned char*)lds;
    F.MISC = nullptr;
    F.tid = threadIdx.x; F.lane = F.tid & 63; F.wave = __builtin_amdgcn_readfirstlane(F.tid >> 6);
    F.G = gridDim.x; { const int bx = blockIdx.x; F.vcu = (F.G % 8 == 0) ? (bx % 8) * (F.G / 8) + bx / 8 : bx; }
    F.ctl = (gu32*)(opq_ptr(args.ws) + WS_CTL);
    for (int u = F.tid; u < (LDS_BYTES - LDSCTL_OFF) / 4; u += NWAVES * 64) ((LAS unsigned*)(F.lds + LDSCTL_OFF))[u] = 0u;
    __syncthreads();
    if (MK_ONE_LAUNCH) (void)xcd_barrier_post((unsigned*)(opq_ptr(args.ws) + WS_CTL) + CW_BAR, (volatile LAS unsigned*)(F.lds + MISC_OFF) + 8);
    if (!MK_ONE_LAUNCH) launch_wait((gu32*)(opq_ptr(args.ws) + WS_CTL), args.seq, args.prev_blocks);
    const int lo = args.ph_lo, hi = args.ph_hi;
#define IN(k) (lo <= (k) && (k) < hi)
#define SEAM(k) do { if (MK_ONE_LAUNCH && IN(k) && IN((k) + 1)) { XcdBarrier b_; b_.bar = (unsigned*)(opq_ptr(args.ws) + WS_CTL) + CW_BAR; b_.x = xb_xcc_id(); b_.st = (volatile LAS unsigned*)(F.lds + MISC_OFF) + 8; xcd_barrier(b_, F.wave); } } while (0)
#define XB ((bf16*)(opq_ptr(args.ws) + WS_XB))
#define SSQ ((float*)(opq_ptr(args.ws) + WS_SSQ))
#define U ((bf16*)(opq_ptr(args.ws) + WS_U))
#define xout (opq_ptr(args.out))

    if (EN(9) && IN(0)) { p0_prologue(F, args); SEAM(0); }

    for (int l = 0; l < DEPTH; ++l) {
        const int pb = 1 + 9 * l;
        if (EN(0) && IN(pb + 0)) {
            pg8::Gemm g{XB, (const bf16*)(opq_ptr(args.ws) + WS_W13) + (size_t)(l * 2 + 0) * N13 * DM, M, N13, DM, DM}; pg8::StaticOrder S; S.init(M, N13, OPQ(F.G), OPQ((int)blockIdx.x));
            EpiSwiGLU E{U, SSQ};
            pg8::gemm_phase<EpiSwiGLU, pg8::StaticOrder, true, true>(F.lds + RING_OFF, g, S, E, F.wave);
            SEAM(pb + 0);
        }
        if (EN(1) && IN(pb + 1)) {
            pg8::Gemm g{U, (const bf16*)(opq_ptr(args.ws) + WS_W2) + (size_t)(l * 2 + 0) * DM * DFF, M, DM, DFF, DFF}; pg8::StaticOrder S; S.init(M, DM, OPQ(F.G), OPQ((int)blockIdx.x));
            EpiResid E{l == 0 ? opq_ptr(args.in[0]) : xout, xout, XB, SSQ, 0.5f};
            pg8::gemm_phase<EpiResid, pg8::StaticOrder, true, true>(F.lds + RING_OFF, g, S, E, F.wave);
            SEAM(pb + 1);
        }
        if (EN(2) && IN(pb + 2)) {
            pg8::Gemm g{XB, (const bf16*)(opq_ptr(args.ws) + WS_WIN) + (size_t)l * NIN * DM, M, NIN, DM, DM}; pg8::StaticOrder S; S.init(M, NIN, OPQ(F.G), OPQ((int)blockIdx.x));
            EpiWin E{SSQ, (bf16*)(opq_ptr(args.ws) + WS_QN), (bf16*)(opq_ptr(args.ws) + WS_QM), (bf16*)(opq_ptr(args.ws) + WS_KVH), (bf16*)(opq_ptr(args.ws) + WS_SGN), (bf16*)(opq_ptr(args.ws) + WS_SGM), (float*)(opq_ptr(args.ws) + WS_GN),
                     (float*)(opq_ptr(args.ws) + WS_KMS) + (size_t)l * 16 * 8 * 8 * 64, opq_ptr(args.in[6]) + (size_t)l * 4 * 64, opq_ptr(args.in[7]) + (size_t)l * 2 * 64};
            pg8::gemm_phase<EpiWin, pg8::StaticOrder, true, true>(F.lds + RING_OFF, g, S, E, F.wave);
            SEAM(pb + 2);
        }
        if (EN(3) && IN(pb + 3)) {
#pragma unroll 1
            for (int kv = 0; kv < 2; ++kv) {
                const int cshift = (int)((blockIdx.x + (kv ? F.G / 2 : 0)) % F.G);
                bf16* hid = (bf16*)(opq_ptr(args.ws) + WS_HID) + (size_t)kv * 4096 * 256;
                { pg8::Gemm g{(const bf16*)(opq_ptr(args.ws) + WS_KVH) + (size_t)(2 * kv) * M * 64, (const bf16*)(opq_ptr(args.ws) + WS_WC1) + (size_t)(l * 2 + kv) * 256 * 2048, 4096, 256, 2048, 1024};
                  pg8::StaticOrder S; S.init(4096, 256, OPQ(F.G), OPQ(cshift));
                  EpiCmp1 E{hid, (const float*)(opq_ptr(args.ws) + WS_BC1) + (l * 2 + kv) * 256};
                  pg8::gemm_phase<EpiCmp1, pg8::StaticOrder, true, true>(F.lds + RING_OFF, g, S, E, F.wave); }
                VM_WAIT(); __syncthreads();
                { pg8::Gemm g{hid, (const bf16*)(opq_ptr(args.ws) + WS_WC2) + (size_t)(l * 2 + kv) * 256 * 256, 4096, 256, 256, 256};
                  pg8::StaticOrder S; S.init(4096, 256, OPQ(F.G), OPQ(cshift));
                  EpiCmp2 E{(bf16*)(opq_ptr(args.ws) + WS_CMP) + (size_t)kv * 4096 * 64, kv == 0 ? opq_ptr(args.in[6]) + (size_t)l * 4 * 64 + 64 : nullptr};
                  pg8::gemm_phase<EpiCmp2, pg8::StaticOrder, true, true>(F.lds + RING_OFF, g, S, E, F.wave); }
            }
            SEAM(pb + 3);
        }
        if (EN(4) && IN(pb + 4)) { SEAM(pb + 4); }
        if (EN(5) && IN(pb + 5)) {
            pg8::Gemm g{XB  , (const bf16*)(opq_ptr(args.ws) + WS_WUP) + (size_t)l * NUP * DM, M, NUP, DM, DM}; pg8::StaticOrder S; S.init(M, NUP, OPQ(F.G), OPQ((int)blockIdx.x));
            EpiUp E{(bf16*)(opq_ptr(args.ws) + WS_Y), (const bf16*)(opq_ptr(args.ws) + WS_SGN), (const bf16*)(opq_ptr(args.ws) + WS_SGM)};
            pg8::gemm_phase<EpiUp, pg8::StaticOrder, true, true>(F.lds + RING_OFF, g, S, E, F.wave);
            SEAM(pb + 5);
        }
        if (EN(6) && IN(pb + 6)) {
            pg8::Gemm g{(const bf16*)(opq_ptr(args.ws) + WS_Y), (const bf16*)(opq_ptr(args.ws) + WS_WOUT) + (size_t)l * DM * DM, M, DM, DM, DM}; pg8::StaticOrder S; S.init(M, DM, OPQ(F.G), OPQ((int)blockIdx.x));
            EpiResid E{xout, xout, XB, SSQ, 1.0f};
            pg8::gemm_phase<EpiResid, pg8::StaticOrder, true, true>(F.lds + RING_OFF, g, S, E, F.wave);
            SEAM(pb + 6);
        }
        if (EN(7) && IN(pb + 7)) {
            pg8::Gemm g{XB, (const bf16*)(opq_ptr(args.ws) + WS_W13) + (size_t)(l * 2 + 1) * N13 * DM, M, N13, DM, DM}; pg8::StaticOrder S; S.init(M, N13, OPQ(F.G), OPQ((int)blockIdx.x));
            EpiSwiGLU E{U, SSQ};
            pg8::gemm_phase<EpiSwiGLU, pg8::StaticOrder, true, true>(F.lds + RING_OFF, g, S, E, F.wave);
            SEAM(pb + 7);
        }
        if (EN(8) && IN(pb + 8)) {
            pg8::Gemm g{U, (const bf16*)(opq_ptr(args.ws) + WS_W2) + (size_t)(l * 2 + 1) * DM * DFF, M, DM, DFF, DFF}; pg8::StaticOrder S; S.init(M, DM, OPQ(F.G), OPQ((int)blockIdx.x));
            EpiResid E{xout, xout, XB, SSQ, 0.5f};
            pg8::gemm_phase<EpiResid, pg8::StaticOrder, true, true>(F.lds + RING_OFF, g, S, E, F.wave);
            SEAM(pb + 8);
        }
    }
    if (!MK_ONE_LAUNCH) launch_done((gu32*)(opq_ptr(args.ws) + WS_CTL), args.seq);
#undef IN
#undef SEAM
#undef XB
#undef SSQ
#undef U
#undef xout
}

extern "C" void kernel_launch(void* const* d_in, const int* in_sizes, int n_in, void* d_out, int out_size, void* d_ws, size_t ws_size, hipStream_t stream) {
    static int grid = 0;
    if (grid == 0) {
        if (n_in != 14 || in_sizes[0] != M * DM || out_size != M * DM || ws_size < WS_END) { fprintf(stderr, "kernel_launch: unexpected shapes (n_in %d, in0 %d, out %d, ws %zu); nothing launched\n", n_in, n_in > 0 ? in_sizes[0] : -1, out_size, ws_size); grid = -1; return; }
        int dev = 0, cus = 0, per_cu = 0;
        if (hipGetDevice(&dev) != hipSuccess || hipDeviceGetAttribute(&cus, hipDeviceAttributeMultiprocessorCount, dev) != hipSuccess) { grid = -1; return; }
        if (hipFuncSetAttribute((const void*)fwd_kernel, hipFuncAttributeMaxDynamicSharedMemorySize, LDS_BYTES) != hipSuccess) { fprintf(stderr, "kernel_launch: hipFuncSetAttribute failed\n"); grid = -1; return; }
        if (hipOccupancyMaxActiveBlocksPerMultiprocessor(&per_cu, (const void*)fwd_kernel, NWAVES * 64, LDS_BYTES) != hipSuccess || per_cu < 1)
            fprintf(stderr, "kernel_launch: note: occupancy query reports %d workgroups per CU\n", per_cu);
        (void)hipGetLastError();
        grid = cus;
    }
    if (grid < 0) return;
    if (hipMemsetAsync((char*)d_ws + WS_CTL, 0, CTL_ZERO_BYTES, stream) != hipSuccess) return;
    Args a{};
    for (int i = 0; i < 14; ++i) a.in[i] = (const float*)d_in[i];
    a.out = (float*)d_out; a.ws = (unsigned char*)d_ws;
#if MK_ONE_LAUNCH
    a.ph_lo = 0; a.ph_hi = N_PHASES;
    hipLaunchKernelGGL(fwd_kernel, dim3(grid), dim3(NWAVES * 64), LDS_BYTES, stream, a);
#else
    int seq = 0, prev = 0;
    for (int p = 0; p < RUN_PHASES; ++p) {
        a.ph_lo = p; a.ph_hi = p + 1;
        const int k = (p - 1) % 9, l = (p - 1) / 9;
        if (p >= 1 && k == 4) { a.seq = seq++; a.prev_blocks = prev; prev = 4 * grid; hipLaunchKernelGGL(slow_nsa_kernel, dim3(4 * grid), dim3(256), 0, stream, a, l); continue; }
        a.seq = seq++; a.prev_blocks = prev; prev = grid;
        hipLaunchKernelGGL(fwd_kernel, dim3(grid), dim3(NWAVES * 64), LDS_BYTES, stream, a);
        if (p >= 1 && k == 3) { a.seq = seq++; a.prev_blocks = prev; prev = 4 * grid; hipLaunchKernelGGL(slow_moba_kernel, dim3(4 * grid), dim3(256), 0, stream, a, l); }
    }
#endif
}
```

```cpp
#define FAST_ATTN 3
#define MK_ONE_LAUNCH 1
#include <hip/hip_runtime.h>
#include <cstdio>
#include <cstdint>
namespace pg8 {
#define PG8_LAS __attribute__((address_space(3)))
typedef unsigned short bf16_t;
typedef short bf16x8 __attribute__((ext_vector_type(8)));
typedef float f32x4 __attribute__((ext_vector_type(4)));
typedef unsigned u32x4 __attribute__((ext_vector_type(4)));
constexpr int BM = 256, BK = 64, HALF = 128, HTB = HALF * BK * 2  , STAGE_BYTES = 8 * HTB, NXCD = 8, WGM = 8;

__host__ __device__ __forceinline__ int lds_byte(int r, int c) { const int st = (r >> 4) * 2 + (c >> 5), rr = r & 15, cc = c & 31, ob = rr * 64 + cc * 2; return st * 1024 + (ob ^ (((ob >> 9) & 1) << 5)); }
__host__ __device__ __forceinline__ void stage_rc(int b, int& R, int& C) { const int st = b / 1024, sb = b % 1024, swz = sb ^ (((sb >> 9) & 1) << 5); R = (st >> 1) * 16 + swz / 64; C = (st & 1) * 32 + (swz % 64) / 2; }
__host__ __device__ __forceinline__ int perm32(int rho) { const int n = rho >> 4, i = rho & 15; return 8 * (i >> 2) + 4 * n + (i & 3); }

struct Unit { int pm, pn; };
template <class T, class = void> struct HasMid { static constexpr bool value = false; };
template <class T> struct HasMid<T, decltype((void)T::MID_HOOK)> { static constexpr bool value = T::MID_HOOK; };
struct Gemm { const bf16_t* A; const bf16_t* Bt; int M, N, K, lda; };

struct StaticOrder {
    int nM, nN, nwg, G, c;
    __host__ __device__ void init(int M, int N, int G_, int c_) { nM = M / BM; nN = N / BM; nwg = nM * nN; G = G_; c = c_; }
    __host__ __device__ bool next(int i, Unit& u) const {
        const long L = (long)i * G + c; if (L >= nwg) return false;
        int wgid = (int)L; { const int q = nwg / NXCD, r = nwg % NXCD, xcd = wgid % NXCD, off = wgid / NXCD; wgid = (xcd < r ? xcd * (q + 1) : r * (q + 1) + (xcd - r) * q) + off; }
        const int nig = WGM * nN, gid = wgid / nig, fm = gid * WGM, gsz = (nM - fm) < WGM ? (nM - fm) : WGM;
        u.pm = fm + ((wgid % nig) % gsz); u.pn = (wgid % nig) / gsz; return true;
    }
    __device__ __forceinline__ void a_ready(const Unit&) const {}
    __device__ __forceinline__ void done(const Unit&) const {}
};

typedef float f32x2_cv __attribute__((ext_vector_type(2))); typedef __bf16 bf16x2_cv __attribute__((ext_vector_type(2)));
__device__ __forceinline__ unsigned cvt_pk_bf16(float lo, float hi) { f32x2_cv v = {lo, hi}; bf16x2_cv b = __builtin_convertvector(v, bf16x2_cv); return __builtin_bit_cast(unsigned, b); }
typedef float f32x2 __attribute__((ext_vector_type(2)));
template <class Epi, class Sched, bool ALIGN_EPI = false, bool SP2 = false>
__device__ __forceinline__ void gemm_phase(PG8_LAS unsigned char* lds, const Gemm g, const Sched& S, const Epi& E, const int wave_id  ) {
    int tid_; asm volatile("v_mbcnt_lo_u32_b32 %0, -1, 0\n\tv_mbcnt_hi_u32_b32 %0, -1, %0" : "=v"(tid_)); tid_ += wave_id * 64;
    const int tid = tid_, wid = __builtin_amdgcn_readfirstlane(tid >> 6), lane = tid & 63, wr = wid >> 2, wc = wid & 3, fr = lane & 15, fq = lane >> 4;
    const int K = g.K, nt = K / BK;
    unsigned voffA[2], voffB[2];
#pragma unroll
    for (int i = 0; i < 2; ++i) { int R, C; stage_rc(tid * 16 + i * 8192, R, C); const int Rb = Epi::PERM ? ((R & ~31) + perm32(R & 31)) : R;
        voffA[i] = (unsigned)(R * g.lda + C) * 2u; voffB[i] = (unsigned)(Rb * K + C) * 2u; }
    const size_t kstep = (size_t)(BK * 2);
    const size_t hstep = (size_t)HALF * K * 2;
    const size_t tstep = 2 * hstep; const size_t hstepA = (size_t)HALF * g.lda * 2, tstepA = 2 * hstepA;
    const unsigned ldsw = (unsigned)wid * 1024u;
    const int aoff = lds_byte(wr * 64 + fr, fq * 8), boff = lds_byte(wc * 32 + fr, fq * 8);
#define PG8_SA(b, h) (((b) * 2 + (h)) * HTB)
#define PG8_SB(b, h) ((4 + (b) * 2 + (h)) * HTB)
#define PG8_STAGE(bufoff, gbase, voff) do { _Pragma("unroll") for (int _i = 0; _i < 2; ++_i) \
        __builtin_amdgcn_global_load_lds((const unsigned*)((const char*)(gbase) + (voff)[_i]), (PG8_LAS unsigned*)(lds + (bufoff) + ldsw + _i * 8192), 16, 0, 0); } while (0)
#define PG8_LDA(dst, b, h) do { _Pragma("unroll") for (int m = 0; m < 4; ++m) _Pragma("unroll") for (int k = 0; k < 2; ++k) dst[m][k] = *(const PG8_LAS bf16x8*)(lds + PG8_SA(b, h) + aoff + m * 2048 + k * 1024); } while (0)
#define PG8_LDB(dst, b, h) do { _Pragma("unroll") for (int n = 0; n < 2; ++n) _Pragma("unroll") for (int k = 0; k < 2; ++k) dst[n][k] = *(const PG8_LAS bf16x8*)(lds + PG8_SB(b, h) + boff + n * 2048 + k * 1024); } while (0)
#define PG8_MMA(ai, bj, At, Bt) do { __builtin_amdgcn_s_setprio(1); _Pragma("unroll") for (int m = 0; m < 4; ++m) _Pragma("unroll") for (int n = 0; n < 2; ++n) _Pragma("unroll") for (int k = 0; k < 2; ++k) \
        acc[ai][bj][m][n] = __builtin_amdgcn_mfma_f32_16x16x32_bf16(Bt[n][k], At[m][k], acc[ai][bj][m][n], 0, 0, 0); __builtin_amdgcn_s_setprio(0); } while (0)
#define PG8_WAIT_V(n) asm volatile("s_waitcnt vmcnt(" #n ")" ::: "memory")
#define PG8_WAIT_L(n) asm volatile("s_waitcnt lgkmcnt(" #n ")" ::: "memory")
#define PG8_BAR __builtin_amdgcn_s_barrier()
#define PG8_SCHED __builtin_amdgcn_sched_barrier(0)
    Unit cur, nxt; int ui = 0;
    if (!S.next(0, cur)) return;
    f32x4 acc[2][2][4][2];
#pragma unroll
    for (int a = 0; a < 2; ++a)
#pragma unroll
        for (int b = 0; b < 2; ++b)
#pragma unroll
            for (int m = 0; m < 4; ++m)
#pragma unroll
                for (int n = 0; n < 2; ++n) acc[a][b][m][n] = (f32x4){0.f, 0.f, 0.f, 0.f};
    bf16x8 At[4][2], B0[2][2], B1[2][2];
    const char* cA = (const char*)g.A + (size_t)cur.pm * tstepA; const char* cB = (const char*)g.Bt + (size_t)cur.pn * tstep;
    S.a_ready(cur);
    if constexpr (SP2) {
        PG8_STAGE(PG8_SB(0, 0), cB, voffB); PG8_STAGE(PG8_SB(0, 1), cB + hstep, voffB); PG8_STAGE(PG8_SA(0, 0), cA, voffA); PG8_STAGE(PG8_SA(0, 1), cA + hstepA, voffA);
        if (wr == 1) PG8_BAR;
        PG8_WAIT_V(2); PG8_BAR;
        PG8_STAGE(PG8_SB(1, 0), cB + kstep, voffB); PG8_STAGE(PG8_SA(1, 0), cA + kstep, voffA); PG8_STAGE(PG8_SB(1, 1), cB + hstep + kstep, voffB);
        PG8_WAIT_V(6); PG8_BAR;
    } else {
        PG8_STAGE(PG8_SB(0, 0), cB, voffB); PG8_STAGE(PG8_SA(0, 0), cA, voffA); PG8_STAGE(PG8_SB(0, 1), cB + hstep, voffB); PG8_STAGE(PG8_SA(0, 1), cA + hstepA, voffA);
        if (wr == 1) PG8_BAR;
        PG8_WAIT_V(4); PG8_BAR;
        PG8_STAGE(PG8_SB(1, 0), cB + kstep, voffB); PG8_STAGE(PG8_SA(1, 0), cA + kstep, voffA); PG8_STAGE(PG8_SB(1, 1), cB + hstep + kstep, voffB);
        PG8_WAIT_V(6); PG8_BAR;
    }
    for (;;) {
        const bool has_next = S.next(ui + 1, nxt);
        const char* nA = has_next ? (const char*)g.A + (size_t)nxt.pm * tstepA : cA; const char* nB = has_next ? (const char*)g.Bt + (size_t)nxt.pn * tstep : cB;
        for (int t = 0; t < nt; t += 2) {
            if constexpr (HasMid<Epi>::value) { if (t == nt / 2) { int lm_; asm volatile("v_mbcnt_lo_u32_b32 %0, -1, 0\n\tv_mbcnt_hi_u32_b32 %0, -1, %0" : "=v"(lm_)); E.mid(acc, cur, wr, wc, lm_ & 15, lm_ >> 4); } }
            const bool last = (t == nt - 2);
            const char* a1 = cA + (size_t)(t + 1) * kstep;
            const char* a2 = last ? nA : cA + (size_t)(t + 2) * kstep; const char* b2 = last ? nB : cB + (size_t)(t + 2) * kstep;
            const char* a3 = a2 + kstep; const char* b3 = b2 + kstep;
            if (last && has_next) S.a_ready(nxt);
            if constexpr (SP2) {
            PG8_LDB(B0, 0, 0); PG8_LDB(B1, 0, 1); PG8_SCHED; PG8_LDA(At, 0, 0); PG8_STAGE(PG8_SA(1, 1), a1 + hstepA, voffA);
            PG8_WAIT_V(8); PG8_WAIT_L(0); PG8_BAR; PG8_MMA(0, 0, At, B0); PG8_MMA(0, 1, At, B1); PG8_BAR; PG8_SCHED;
            PG8_LDA(At, 0, 1); PG8_STAGE(PG8_SB(0, 0), b2, voffB); PG8_STAGE(PG8_SB(0, 1), b2 + hstep, voffB); PG8_STAGE(PG8_SA(0, 0), a2, voffA);
            PG8_WAIT_V(8); PG8_WAIT_L(0); PG8_BAR; PG8_MMA(1, 0, At, B0); PG8_MMA(1, 1, At, B1); PG8_BAR; PG8_SCHED;
            PG8_LDB(B0, 1, 0); PG8_LDB(B1, 1, 1); PG8_SCHED; PG8_LDA(At, 1, 0); PG8_STAGE(PG8_SA(0, 1), a2 + hstepA, voffA);
            PG8_WAIT_V(8); PG8_WAIT_L(0); PG8_BAR; PG8_MMA(0, 0, At, B0); PG8_MMA(0, 1, At, B1); PG8_BAR; PG8_SCHED;
            PG8_LDA(At, 1, 1); PG8_STAGE(PG8_SB(1, 0), b3, voffB); PG8_STAGE(PG8_SB(1, 1), b3 + hstep, voffB); PG8_STAGE(PG8_SA(1, 0), a3, voffA);
            PG8_WAIT_V(8); PG8_WAIT_L(0); PG8_BAR; PG8_MMA(1, 0, At, B0); PG8_MMA(1, 1, At, B1); PG8_BAR; PG8_SCHED;
            } else {
            PG8_LDB(B0, 0, 0); PG8_SCHED; PG8_LDA(At, 0, 0); PG8_STAGE(PG8_SA(1, 1), a1 + hstepA, voffA);
            PG8_WAIT_L(8); PG8_BAR; PG8_WAIT_L(0); PG8_MMA(0, 0, At, B0); PG8_BAR; PG8_SCHED;
            PG8_LDB(B1, 0, 1); PG8_STAGE(PG8_SB(0, 0), b2, voffB);
            PG8_BAR; PG8_WAIT_L(0); PG8_MMA(0, 1, At, B1); PG8_BAR;
            PG8_LDA(At, 0, 1); PG8_STAGE(PG8_SA(0, 0), a2, voffA);
            PG8_BAR; PG8_WAIT_L(0); PG8_MMA(1, 0, At, B0); PG8_BAR; PG8_SCHED;
            PG8_STAGE(PG8_SB(0, 1), b2 + hstep, voffB);
            PG8_WAIT_V(6); PG8_BAR; PG8_MMA(1, 1, At, B1); PG8_BAR;
            PG8_LDB(B0, 1, 0); PG8_SCHED; PG8_LDA(At, 1, 0); PG8_STAGE(PG8_SA(0, 1), a2 + hstepA, voffA);
            PG8_WAIT_L(8); PG8_BAR; PG8_WAIT_L(0); PG8_MMA(0, 0, At, B0); PG8_BAR; PG8_SCHED;
            PG8_LDB(B1, 1, 1); PG8_STAGE(PG8_SB(1, 0), b3, voffB);
            PG8_BAR; PG8_WAIT_L(0); PG8_MMA(0, 1, At, B1); PG8_BAR;
            PG8_LDA(At, 1, 1); PG8_STAGE(PG8_SA(1, 0), a3, voffA);
            PG8_BAR; PG8_WAIT_L(0); PG8_MMA(1, 0, At, B0); PG8_BAR; PG8_SCHED;
            PG8_STAGE(PG8_SB(1, 1), b3 + hstep, voffB);
            PG8_WAIT_V(6); PG8_BAR; PG8_MMA(1, 1, At, B1); PG8_BAR;
            }
        }
        if constexpr (ALIGN_EPI) { if (wr == 0) PG8_BAR; }
        if constexpr (!Epi::AFTER_DRAIN) { int le_; asm volatile("v_mbcnt_lo_u32_b32 %0, -1, 0\n\tv_mbcnt_hi_u32_b32 %0, -1, %0" : "=v"(le_));   E(acc, cur, wr, wc, le_ & 15, le_ >> 4); S.done(cur); }
        if (!has_next) break;
#pragma unroll
        for (int a = 0; a < 2; ++a)
#pragma unroll
            for (int b = 0; b < 2; ++b)
#pragma unroll
                for (int m = 0; m < 4; ++m)
#pragma unroll
                    for (int n = 0; n < 2; ++n) acc[a][b][m][n] = (f32x4){0.f, 0.f, 0.f, 0.f};
        cur = nxt; cA = nA; cB = nB; ++ui;
        if constexpr (ALIGN_EPI) { if (wr == 1) PG8_BAR; }
    }
    PG8_WAIT_V(0);
    if constexpr (!ALIGN_EPI) { if (wr == 0) PG8_BAR; }
    PG8_BAR;
    if constexpr (Epi::AFTER_DRAIN) { E.fused(acc, cur, wr, wc, fr, fq, lds, wid, lane); S.done(cur); }
#undef PG8_SA
#undef PG8_SB
#undef PG8_STAGE
#undef PG8_LDA
#undef PG8_LDB
#undef PG8_MMA
#undef PG8_WAIT_V
#undef PG8_WAIT_L
#undef PG8_BAR
#undef PG8_SCHED
}
}
#define GAS __attribute__((address_space(1)))
#define LAS __attribute__((address_space(3)))
typedef unsigned short bf16;
typedef unsigned v4u __attribute__((ext_vector_type(4)));
typedef float f32x4 __attribute__((ext_vector_type(4)));
typedef short bf16x8 __attribute__((ext_vector_type(8)));
typedef GAS unsigned gu32;
typedef GAS unsigned long long gu64;
#define RLX_AGENT __ATOMIC_RELAXED, __HIP_MEMORY_SCOPE_AGENT
#define LDS_WAIT() asm volatile("s_waitcnt lgkmcnt(0)" ::: "memory")
#define VM_WAIT() asm volatile("s_waitcnt vmcnt(0)" ::: "memory")
__device__ __forceinline__ unsigned long long rt() { return __builtin_amdgcn_s_memrealtime(); }
__device__ __forceinline__ unsigned f2bf(float f) { unsigned u = __builtin_bit_cast(unsigned, f); return (u + 0x7fffu + ((u >> 16) & 1u)) >> 16; }
__device__ __forceinline__ unsigned pk2(float lo, float hi) { return f2bf(lo) | (f2bf(hi) << 16); }
#define XB_TMO      128
#define XB_XCNT(j)  (256  + 64 * (j))
#define XB_XSUB(j)  (1280 + 64 * (j))
#define XB_XGEN(j)  (2304 + 64 * (j))
#define XB_TOP      3328
#define XB_TOPGEN   3392
#define XCD_BAR_WORDS 3456
#define XB_SPIN_CAP (1u << 18)

__device__ __forceinline__ unsigned xb_ld(unsigned* p)              { return __hip_atomic_load((GAS unsigned*)p, __ATOMIC_RELAXED, __HIP_MEMORY_SCOPE_AGENT); }
__device__ __forceinline__ unsigned xb_add(unsigned* p, unsigned v) { return __hip_atomic_fetch_add((GAS unsigned*)p, v, __ATOMIC_RELAXED, __HIP_MEMORY_SCOPE_AGENT); }
__device__ __forceinline__ unsigned xb_xcc_id() { return (unsigned)__builtin_amdgcn_s_getreg((3 << 11) | 20) & 0xFu; }
#define XB_SPIN(cond, bar) do { unsigned _sp = 0; while (cond) { __builtin_amdgcn_s_sleep(1); \
    if ((++_sp & 255u) == 0u) { if (xb_ld(&(bar)[XB_TMO])) break; if (_sp > XB_SPIN_CAP) { xb_add(&(bar)[XB_TMO], 1u); break; } } } } while (0)

struct XcdBarrier {
    unsigned* bar; unsigned x;
    volatile LAS unsigned* st;
};

__device__ __forceinline__ XcdBarrier xcd_barrier_post(unsigned* bar, volatile LAS unsigned* st) {
    XcdBarrier b; b.bar = bar; b.x = xb_xcc_id(); b.st = st;
    if (threadIdx.x == 0) (void)xb_add(&bar[XB_XCNT(b.x)], 1u);
    return b;
}
__device__ __forceinline__ void xcd_barrier_complete(unsigned* bar, unsigned x, unsigned& nloc, unsigned& nx) {
    const unsigned G = gridDim.x * gridDim.y * gridDim.z;
    unsigned sum, cnt, mine, sp = 0u;
    for (;;) {
        sum = 0u; cnt = 0u; mine = 0u;
#pragma unroll
        for (unsigned j = 0; j < 16; ++j) { const unsigned c = xb_ld(&bar[XB_XCNT(j)]); sum += c; cnt += (c > 0u) ? 1u : 0u; mine = (j == x) ? c : mine; }
        if (sum == G) break;
        __builtin_amdgcn_s_sleep(1);
        if ((++sp & 255u) == 0u) { if (xb_ld(&bar[XB_TMO])) break; if (sp > XB_SPIN_CAP) { xb_add(&bar[XB_TMO], 1u); break; } }
    }
    nloc = mine > 0u ? mine : 1u; nx = cnt > 0u ? cnt : 1u;
}

__device__ __forceinline__ void xcd_barrier(const XcdBarrier& b, const int wave_id) {
    asm volatile("s_waitcnt vmcnt(0)" ::: "memory");
    __syncthreads();
    int lane_; asm volatile("v_mbcnt_lo_u32_b32 %0, -1, 0\n\tv_mbcnt_hi_u32_b32 %0, -1, %0" : "=v"(lane_));
    if (wave_id == 0 && lane_ == 0) {
        unsigned* bar = b.bar;
        __builtin_amdgcn_s_waitcnt(0);
        unsigned nloc = b.st[0], nx = b.st[1];
        if (nloc == 0u) { xcd_barrier_complete(bar, b.x, nloc, nx); b.st[0] = nloc; b.st[1] = nx; }
        const unsigned old = xb_add(&bar[XB_XSUB(b.x)], 1u);
        const unsigned gen = old / nloc;
        if (old + 1u == (gen + 1u) * nloc) {
            __builtin_amdgcn_fence(__ATOMIC_RELEASE, "agent");
            asm volatile("s_waitcnt vmcnt(0)" ::: "memory");
            const unsigned og = xb_add(&bar[XB_TOP], 1u);
            const unsigned tg = og / nx;
            if (og + 1u == (tg + 1u) * nx) xb_add(&bar[XB_TOPGEN], 1u);
            else XB_SPIN(xb_ld(&bar[XB_TOPGEN]) == tg, bar);
            __builtin_amdgcn_fence(__ATOMIC_ACQUIRE, "agent");
            xb_add(&bar[XB_XGEN(b.x)], 1u);
            asm volatile("s_waitcnt vmcnt(0)" ::: "memory");
        } else {
            XB_SPIN(xb_ld(&bar[XB_XGEN(b.x)]) == gen, bar);
            __builtin_amdgcn_fence(__ATOMIC_ACQUIRE, "agent");
            asm volatile("s_waitcnt vmcnt(0)" ::: "memory");
        }
    }
    __syncthreads();
}
constexpr int NWAVES = 8;
constexpr int DM = 1024, BATCH = 16, SEQ = 2048, DEPTH = 2, M = BATCH * SEQ, DFF = 2816, INC = 4888;
constexpr int N13 = 2 * DFF, NIN = 5120, NUP = 2048;
constexpr float LOG2E = 1.4426950408889634f;
constexpr float C2 = 0.125f * LOG2E;
constexpr size_t MiB = 1u << 20;
constexpr size_t WS_CTL = 0, CTL_ZERO_BYTES = 2 * MiB;
constexpr size_t WS_KMS = 1 * MiB;
constexpr size_t WS_W13 = 2 * MiB;
constexpr size_t WS_W2 = 46 * MiB;
constexpr size_t WS_WIN = 68 * MiB;
constexpr size_t WS_WUP = 88 * MiB;
constexpr size_t WS_WOUT = 96 * MiB;
constexpr size_t WS_WC1 = 100 * MiB;
constexpr size_t WS_WC2 = 104 * MiB;
constexpr size_t WS_BC1 = 104 * MiB + 512 * 1024;
constexpr size_t WS_SSQ = 105 * MiB;
constexpr size_t WS_GN = 107 * MiB;
constexpr size_t WS_HID = 110 * MiB;
constexpr size_t WS_CMP = 114 * MiB;
constexpr size_t WS_XB = 116 * MiB;
constexpr size_t WS_U = 180 * MiB;
constexpr size_t WS_QN = 180 * MiB, WS_QM = 212 * MiB, WS_KVH = 244 * MiB;
constexpr size_t WS_Y = 180 * MiB;
constexpr size_t WS_SGN = 356 * MiB, WS_SGM = 420 * MiB;
constexpr size_t WS_END = 484 * MiB;
constexpr int CW_TMO = 0, CW_CODE = 1, CW_BAR = 4096, CW_QUEUE = 40960;
constexpr int RING_OFF = 0, RING_BYTES = 131072;
constexpr int LDSCTL_OFF = RING_BYTES, MISC_OFF = LDSCTL_OFF + 320;
constexpr int LDS_BYTES = 147456;
constexpr int RINV_OFF = LDSCTL_OFF + 1024;

using pg8::Unit; using pg8::BM; using pg8::HALF;
typedef unsigned u32x4 __attribute__((ext_vector_type(4)));

__device__ __forceinline__ float bf_lo(unsigned u) { return __uint_as_float(u << 16); }
__device__ __forceinline__ float bf_hi(unsigned u) { return __uint_as_float(u & 0xffff0000u); }
__device__ __forceinline__ float fsigmoid(float v) { return __builtin_amdgcn_rcpf(1.0f + __builtin_amdgcn_exp2f(-LOG2E * v)); }
__device__ __forceinline__ u32x4 pack8(f32x4 a, f32x4 b) { u32x4 w; w.x = pg8::cvt_pk_bf16(a[0], a[1]); w.y = pg8::cvt_pk_bf16(a[2], a[3]); w.z = pg8::cvt_pk_bf16(b[0], b[1]); w.w = pg8::cvt_pk_bf16(b[2], b[3]); return w; }
__device__ __forceinline__ float rinv_row(const float* ssq, int row) {
    const GAS f32x4* p = (const GAS f32x4*)(ssq + (size_t)row * 16);
    const f32x4 a = p[0], b = p[1], c = p[2], d = p[3];
    const float s = (((a[0] + a[1]) + (a[2] + a[3])) + ((b[0] + b[1]) + (b[2] + b[3]))) + (((c[0] + c[1]) + (c[2] + c[3])) + ((d[0] + d[1]) + (d[2] + d[3])));
    return 1.0f / sqrtf(s * (1.0f / 1024.0f) + 1e-6f);
}
__device__ __forceinline__ float dot4(f32x4 a) { return (a[0] * a[0] + a[1] * a[1]) + (a[2] * a[2] + a[3] * a[3]); }

template <int MASK> __device__ __forceinline__ float swz_xor(float v) { return __builtin_bit_cast(float, __builtin_amdgcn_ds_swizzle(__builtin_bit_cast(int, v), (MASK << 10) | 0x1f)); }
__device__ __forceinline__ float add_xor32(float v) { const unsigned u = __builtin_bit_cast(unsigned, v); auto rr = __builtin_amdgcn_permlane32_swap(u, u, false, false); return __builtin_bit_cast(float, (unsigned)rr[0]) + __builtin_bit_cast(float, (unsigned)rr[1]); }
__device__ __forceinline__ float get_xor32(float v, int hi) { const unsigned u = __builtin_bit_cast(unsigned, v); auto rr = __builtin_amdgcn_permlane32_swap(u, u, false, false); return __builtin_bit_cast(float, (unsigned)(hi ? rr[0] : rr[1])); }

struct RinvTab { int pmA, pmB; LAS const float* tab; const float* ssq; };
__device__ __forceinline__ RinvTab rinv_fill(LAS unsigned char* lds_base, const float* ssq, const pg8::StaticOrder& S, int n_units_max, int wave_id) {
    int t_; asm volatile("v_mbcnt_lo_u32_b32 %0, -1, 0\n\tv_mbcnt_hi_u32_b32 %0, -1, %0" : "=v"(t_)); t_ += wave_id * 64;
    pg8::Unit u0, u1; u0.pm = 0; u0.pn = 0; u1 = u0;
    S.next(0, u0); int last = 0;
    for (int i = 1; i < n_units_max; ++i) { pg8::Unit t; if (S.next(i, t)) { u1 = t; last = i; } }
    if (last == 0) u1 = u0;
    const int pmA = u0.pm, pmB = u1.pm;
    LAS float* tab = (LAS float*)(lds_base + RINV_OFF);
    const int row = (t_ < 256 ? pmA : pmB) * 256 + (t_ & 255);
    tab[t_] = rinv_row(ssq, row);
    __syncthreads();
    RinvTab R; R.pmA = pmA; R.pmB = pmB; R.tab = tab; R.ssq = ssq; return R;
}
__device__ __forceinline__ float rinv_get(const RinvTab& R, int pm, int r256) {
    if (pm == R.pmA) return R.tab[r256];
    if (pm == R.pmB) return R.tab[256 + r256];
    return rinv_row(R.ssq, pm * 256 + r256);
}
typedef float f32x2e __attribute__((ext_vector_type(2)));
__device__ __forceinline__ f32x2e sigmoid2(f32x2e a, float c) { const f32x2e z = a * c; f32x2e e; e.x = __builtin_amdgcn_exp2f(z.x); e.y = __builtin_amdgcn_exp2f(z.y); const f32x2e t = e + 1.0f; f32x2e s_; s_.x = __builtin_amdgcn_rcpf(t.x); s_.y = __builtin_amdgcn_rcpf(t.y); return s_; }
__device__ __forceinline__ unsigned pk_bf16x2(f32x2e v) { return pg8::cvt_pk_bf16(v.x, v.y); }
struct EpiSwiGLU {
    static constexpr bool PERM = true, AFTER_DRAIN = false;
    bf16* U; RinvTab R;
    __device__ __forceinline__ void operator()(const f32x4 (&acc)[2][2][4][2], const Unit& u, int wr, int wc, int fr, int fq) const {
        const int row0 = u.pm * BM + wr * 64 + fr, col0 = u.pn * 128 + wc * 32 + 8 * fq;
#pragma unroll
        for (int ai = 0; ai < 2; ++ai)
#pragma unroll
            for (int m = 0; m < 4; ++m) { const int row = row0 + ai * HALF + m * 16; const float r = rinv_get(R, u.pm, row & 255);
                const float c = -LOG2E * r, r2 = r * r;
                u32x4 w;
#pragma unroll
                for (int n = 0; n < 2; ++n) { const f32x4 g4 = acc[ai][0][m][n], u4 = acc[ai][1][m][n];
#pragma unroll
                    for (int h2 = 0; h2 < 2; ++h2) { const f32x2e g = (f32x2e){g4[2 * h2], g4[2 * h2 + 1]}, v = (f32x2e){u4[2 * h2], u4[2 * h2 + 1]};
                        const f32x2e a = g * c; f32x2e e; e.x = __builtin_amdgcn_exp2f(a.x); e.y = __builtin_amdgcn_exp2f(a.y);
                        const f32x2e t = e + 1.0f; f32x2e s; s.x = __builtin_amdgcn_rcpf(t.x); s.y = __builtin_amdgcn_rcpf(t.y);
                        const f32x2e h = (g * v) * (s * r2);
                        w[2 * n + h2] = pg8::cvt_pk_bf16(h.x, h.y); } }
                *(GAS u32x4*)(U + (size_t)row * DFF + col0) = w;
                if (m & 1) asm volatile("" ::: "memory"); }
    }
};
struct EpiResid {
    static constexpr bool PERM = true, AFTER_DRAIN = false;
    float* xdst; bf16* xb; float* ssq; float coef;
    __device__ __forceinline__ void operator()(const f32x4 (&acc)[2][2][4][2], const Unit& u, int wr, int wc, int fr, int fq) const {
        const int row0 = u.pm * BM + wr * 64 + fr, col0 = u.pn * BM + wc * 32 + 8 * fq;
        u32x4 xin[2][4][2];
#pragma unroll
        for (int ai = 0; ai < 2; ++ai)
#pragma unroll
            for (int m = 0; m < 4; ++m)
#pragma unroll
                for (int bj = 0; bj < 2; ++bj) xin[ai][m][bj] = *(const GAS u32x4*)(xb + (size_t)(row0 + ai * HALF + m * 16) * DM + col0 + bj * HALF);
        asm volatile("" ::: "memory");
#pragma unroll
        for (int ai = 0; ai < 2; ++ai)
#pragma unroll
            for (int m = 0; m < 4; ++m) { const int row = row0 + ai * HALF + m * 16; f32x2e sq2 = (f32x2e){0.f, 0.f};
#pragma unroll
                for (int bj = 0; bj < 2; ++bj) { const size_t off = (size_t)row * DM + col0 + bj * HALF;
                    const u32x4 xo = xin[ai][m][bj];
                    const f32x4 a0 = acc[ai][bj][m][0], a1 = acc[ai][bj][m][1];
                    const f32x2e y0 = (f32x2e){bf_lo(xo.x), bf_hi(xo.x)} + (f32x2e){a0[0], a0[1]} * coef, y1 = (f32x2e){bf_lo(xo.y), bf_hi(xo.y)} + (f32x2e){a0[2], a0[3]} * coef;
                    const f32x2e y2 = (f32x2e){bf_lo(xo.z), bf_hi(xo.z)} + (f32x2e){a1[0], a1[1]} * coef, y3 = (f32x2e){bf_lo(xo.w), bf_hi(xo.w)} + (f32x2e){a1[2], a1[3]} * coef;
                    if (xdst) { *(GAS f32x4*)(xdst + off) = (f32x4){y0.x, y0.y, y1.x, y1.y}; *(GAS f32x4*)(xdst + off + 4) = (f32x4){y2.x, y2.y, y3.x, y3.y}; }
                    u32x4 w; w.x = pk_bf16x2(y0); w.y = pk_bf16x2(y1); w.z = pk_bf16x2(y2); w.w = pk_bf16x2(y3);
                    *(GAS u32x4*)(xb + off) = w;
                    sq2 += y0 * y0; sq2 += y1 * y1; sq2 += y2 * y2; sq2 += y3 * y3; }
                float sq = sq2.x + sq2.y;
                sq += swz_xor<16>(sq); sq = add_xor32(sq);
                if (fq == 0) *(GAS float*)(ssq + (size_t)row * 16 + u.pn * 4 + wc) = sq;
                if (m & 1) asm volatile("" ::: "memory"); }
    }
};
struct EpiUpA {
    static constexpr bool PERM = true, AFTER_DRAIN = false;
    bf16* Y; const bf16* sg;
    __device__ __forceinline__ void operator()(const f32x4 (&acc)[2][2][4][2], const Unit& u, int wr, int wc, int fr, int fq) const {
        const int row0 = u.pm * BM + wr * 64 + fr, col0 = u.pn * BM + wc * 32 + 8 * fq;
#pragma unroll
        for (int ai = 0; ai < 2; ++ai)
#pragma unroll
            for (int m = 0; m < 4; ++m) { const int row = row0 + ai * HALF + m * 16;
#pragma unroll
                for (int bj = 0; bj < 2; ++bj) { const size_t off = (size_t)row * DM + col0 + bj * HALF;
                    const u32x4 a = *(const GAS u32x4*)(sg + off);
                    const f32x4 g0 = (f32x4){bf_lo(a.x), bf_hi(a.x), bf_lo(a.y), bf_hi(a.y)}, g1 = (f32x4){bf_lo(a.z), bf_hi(a.z), bf_lo(a.w), bf_hi(a.w)};
                    *(GAS u32x4*)(Y + off) = pack8(g0 * acc[ai][bj][m][0], g1 * acc[ai][bj][m][1]); }
                if (m & 1) asm volatile("" ::: "memory"); }
    }
};
struct EpiUpB {
    static constexpr bool PERM = true, AFTER_DRAIN = false;
    bf16* Y; const bf16* sg;
    __device__ __forceinline__ void operator()(const f32x4 (&acc)[2][2][4][2], const Unit& u, int wr, int wc, int fr, int fq) const {
        const int row0 = u.pm * BM + wr * 64 + fr, col0 = u.pn * BM + wc * 32 + 8 * fq;
#pragma unroll
        for (int ai = 0; ai < 2; ++ai)
#pragma unroll
            for (int m = 0; m < 4; ++m) { const int row = row0 + ai * HALF + m * 16;
#pragma unroll
                for (int bj = 0; bj < 2; ++bj) { const size_t off = (size_t)row * DM + col0 + bj * HALF;
                    const u32x4 a = *(const GAS u32x4*)(sg + off), t = *(const GAS u32x4*)(Y + off);
                    const f32x4 g0 = (f32x4){bf_lo(a.x), bf_hi(a.x), bf_lo(a.y), bf_hi(a.y)}, g1 = (f32x4){bf_lo(a.z), bf_hi(a.z), bf_lo(a.w), bf_hi(a.w)};
                    const f32x4 t0 = (f32x4){bf_lo(t.x), bf_hi(t.x), bf_lo(t.y), bf_hi(t.y)}, t1 = (f32x4){bf_lo(t.z), bf_hi(t.z), bf_lo(t.w), bf_hi(t.w)};
                    *(GAS u32x4*)(Y + off) = pack8(t0 + g0 * acc[ai][bj][m][0], t1 + g1 * acc[ai][bj][m][1]); }
                if (m & 1) asm volatile("" ::: "memory"); }
    }
};
struct EpiUp2 {
    static constexpr bool PERM = true, AFTER_DRAIN = false, MID_HOOK = true;
    bf16* Y; const unsigned char* sgn; const unsigned char* sgm;
    typedef unsigned u32x2v __attribute__((ext_vector_type(2)));
    static __device__ __forceinline__ void unpack8(u32x2v q, f32x4& lo, f32x4& hi) {
        lo = (f32x4){(float)(q.x & 0xffu), (float)((q.x >> 8) & 0xffu), (float)((q.x >> 16) & 0xffu), (float)(q.x >> 24)};
        hi = (f32x4){(float)(q.y & 0xffu), (float)((q.y >> 8) & 0xffu), (float)((q.y >> 16) & 0xffu), (float)(q.y >> 24)}; }
    __device__ __forceinline__ void mid(f32x4 (&acc)[2][2][4][2], const Unit& u, int wr, int wc, int fr, int fq) const {
        const int row0 = u.pm * BM + wr * 64 + fr, gcol = u.pn * BM + wc * 64 + 16 * fq;
#pragma unroll
        for (int ai = 0; ai < 2; ++ai) {
            u32x4 qa4[4], qb4[4];
#pragma unroll
            for (int m = 0; m < 4; ++m) { const size_t goff = (size_t)(row0 + ai * HALF + m * 16) * DM + gcol; qa4[m] = *(const GAS u32x4*)(sgn + goff); qb4[m] = *(const GAS u32x4*)(sgm + goff); }
            asm volatile("" ::: "memory");
#pragma unroll
            for (int m = 0; m < 4; ++m) {
                const u32x4 qa = qa4[m], qb = qb4[m];
#pragma unroll
                for (int bj = 0; bj < 2; ++bj) {
                    f32x4 a0, a1, b0, b1; unpack8(bj ? (u32x2v){qa.z, qa.w} : (u32x2v){qa.x, qa.y}, a0, a1); unpack8(bj ? (u32x2v){qb.z, qb.w} : (u32x2v){qb.x, qb.y}, b0, b1);
#pragma unroll
                    for (int e = 0; e < 4; ++e) { acc[ai][bj][m][0][e] *= a0[e] * __builtin_amdgcn_rcpf(b0[e]); acc[ai][bj][m][1][e] *= a1[e] * __builtin_amdgcn_rcpf(b1[e]); } } }
            asm volatile("" ::: "memory"); }
    }
    __device__ __forceinline__ void operator()(const f32x4 (&acc)[2][2][4][2], const Unit& u, int wr, int wc, int fr, int fq) const {
        const int row0 = u.pm * BM + wr * 64 + fr, col0 = u.pn * BM + wc * 32 + 8 * fq, gcol = u.pn * BM + wc * 64 + 16 * fq;
        u32x4 qb8[2][4];
#pragma unroll
        for (int ai = 0; ai < 2; ++ai)
#pragma unroll
            for (int m = 0; m < 4; ++m) qb8[ai][m] = *(const GAS u32x4*)(sgm + (size_t)(row0 + ai * HALF + m * 16) * DM + gcol);
        asm volatile("" ::: "memory");
#pragma unroll
        for (int ai = 0; ai < 2; ++ai)
#pragma unroll
            for (int m = 0; m < 4; ++m) { const int row = row0 + ai * HALF + m * 16;
                const u32x4 qb = qb8[ai][m];
#pragma unroll
                for (int bj = 0; bj < 2; ++bj) { const size_t off = (size_t)row * DM + col0 + bj * HALF;
                    f32x4 g0, g1; unpack8(bj ? (u32x2v){qb.z, qb.w} : (u32x2v){qb.x, qb.y}, g0, g1);
                    *(GAS u32x4*)(Y + off) = pack8(g0 * acc[ai][bj][m][0] * (1.0f / 255.0f), g1 * acc[ai][bj][m][1] * (1.0f / 255.0f)); }
                if (m & 1) asm volatile("" ::: "memory"); }
    }
};
struct EpiCmp1 {
    static constexpr bool PERM = true, AFTER_DRAIN = false;
    bf16* hid; const float* bias;
    __device__ __forceinline__ void operator()(const f32x4 (&acc)[2][2][4][2], const Unit& u, int wr, int wc, int fr, int fq) const {
        const int row0 = u.pm * BM + wr * 64 + fr, col0 = wc * 32 + 8 * fq;
#pragma unroll
        for (int ai = 0; ai < 2; ++ai)
#pragma unroll
            for (int m = 0; m < 4; ++m) { const int row = row0 + ai * HALF + m * 16;
#pragma unroll
                for (int bj = 0; bj < 2; ++bj) { f32x4 h[2];
#pragma unroll
                    for (int n = 0; n < 2; ++n) { const f32x4 v = acc[ai][bj][m][n] + *(const GAS f32x4*)(bias + col0 + bj * HALF + 4 * n);
#pragma unroll
                        for (int i = 0; i < 4; ++i) { const float x = v[i]; h[n][i] = x * fsigmoid(1.5957691216f * (x + 0.044715f * x * x * x)); } }
                    *(GAS u32x4*)(hid + (size_t)row * 256 + col0 + bj * HALF) = pack8(h[0], h[1]); }
                asm volatile("" ::: "memory"); }
    }
};
struct EpiCmp2 {
    static constexpr bool PERM = true, AFTER_DRAIN = false;
    bf16* dst; const float* g;
    __device__ __forceinline__ void operator()(const f32x4 (&acc)[2][2][4][2], const Unit& u, int wr, int wc, int fr, int fq) const {
        if (wc != 0) return;
        const int row0 = u.pm * BM + wr * 64 + fr;
#pragma unroll
        for (int ai = 0; ai < 2; ++ai)
#pragma unroll
            for (int m = 0; m < 4; ++m) { const int row = row0 + ai * HALF + m * 16;
                float ss = 0.f;
#pragma unroll
                for (int bj = 0; bj < 2; ++bj)
#pragma unroll
                    for (int n = 0; n < 2; ++n) ss += dot4(acc[ai][bj][m][n]);
                float hr = 1.0f;
                if (g) { ss += swz_xor<16>(ss); ss = add_xor32(ss); hr = 1.0f / sqrtf(ss * (1.0f / 64.0f) + 1e-6f); }
#pragma unroll
                for (int bj = 0; bj < 2; ++bj) { f32x4 v[2];
#pragma unroll
                    for (int n = 0; n < 2; ++n) { const f32x4 gvv = g ? *(const GAS f32x4*)(g + 32 * bj + 8 * fq + 4 * n) : (f32x4){1.f, 1.f, 1.f, 1.f}; v[n] = acc[ai][bj][m][n] * hr * gvv; }
                    *(GAS u32x4*)(dst + (size_t)row * 64 + 32 * bj + 8 * fq) = pack8(v[0], v[1]); }
                asm volatile("" ::: "memory"); }
    }
};
struct EpiWin {
    static constexpr bool PERM = true, AFTER_DRAIN = false;
    RinvTab R; bf16* Qn; bf16* Qm; bf16* KVH; bf16* SGN; bf16* SGM; float* GN; float* KMS; const float* gqn; const float* gqm;
    __device__ __forceinline__ void operator()(const f32x4 (&acc)[2][2][4][2], const Unit& u, int wr, int wc, int fr, int fq) const {
        const int pn = u.pn, row0 = u.pm * BM + wr * 64 + fr;
        if (pn >= 11 && pn <= 18) {
            unsigned char* dst = (unsigned char*)(pn < 15 ? SGN : SGM); const int col0 = 256 * ((pn - 11) & 3) + wc * 64 + 16 * fq;
#pragma unroll
            for (int ai = 0; ai < 2; ++ai)
#pragma unroll
                for (int m = 0; m < 4; ++m) { const int row = row0 + ai * HALF + m * 16; const float r = rinv_get(R, u.pm, row & 255);
                    const float c = -LOG2E * r; unsigned w[2][2];
#pragma unroll
                    for (int bj = 0; bj < 2; ++bj) {
#pragma unroll
                        for (int n = 0; n < 2; ++n) { const f32x4 a4 = acc[ai][bj][m][n];
                            const f32x2e s0 = sigmoid2((f32x2e){a4[0], a4[1]}, c) * 255.0f, s1 = sigmoid2((f32x2e){a4[2], a4[3]}, c) * 255.0f;
                            unsigned q = 0u; q = __builtin_amdgcn_cvt_pk_u8_f32(__builtin_fmaxf(s0.x, 1.0f), 0, q); q = __builtin_amdgcn_cvt_pk_u8_f32(__builtin_fmaxf(s0.y, 1.0f), 1, q);
                            q = __builtin_amdgcn_cvt_pk_u8_f32(__builtin_fmaxf(s1.x, 1.0f), 2, q); q = __builtin_amdgcn_cvt_pk_u8_f32(__builtin_fmaxf(s1.y, 1.0f), 3, q); w[bj][n] = q; } }
                    *(GAS u32x4*)(dst + (size_t)row * DM + col0) = (u32x4){w[0][0], w[0][1], w[1][0], w[1][1]};
                    if (m & 1) asm volatile("" ::: "memory"); }
            return;
        }
        if (pn == 19) {
            if (wc == 0 && fq < 3) {
#pragma unroll
                for (int ai = 0; ai < 2; ++ai)
#pragma unroll
                    for (int m = 0; m < 4; ++m) { const int row = row0 + ai * HALF + m * 16; const float r = rinv_get(R, u.pm, row & 255);
#pragma unroll
                        for (int n = 0; n < 2; ++n) { f32x4 s;
#pragma unroll
                            for (int i = 0; i < 4; ++i) s[i] = fsigmoid(acc[ai][0][m][n][i] * r);
                            *(GAS f32x4*)(GN + (size_t)row * 24 + 8 * fq + 4 * n) = s; } }
            }
            return;
        }
        const bool isq = (pn <= 1) || pn == 5 || pn == 6;
        bf16* base; size_t rstride; const float* g = nullptr; bool kmean = false; float oscale = 1.0f; int hm = 0;
        if (isq) { const int head = (pn <= 1 ? 4 * pn : 4 * (pn - 5)) + wc; base = (pn <= 1 ? Qn : Qm) + 64 * head; rstride = 512; g = pn <= 1 ? gqn : gqm; oscale = C2; }
        else { int slot;
            if (pn == 2) slot = wc; else if (pn == 3) { slot = 4 + wc; g = gqn + 64 * (2 + (wc >> 1)); } else if (pn == 4) slot = 8 + wc;
            else if (pn <= 8) { hm = 4 * (pn - 7) + wc; slot = 12 + hm; g = gqm + 64; kmean = true; } else slot = 20 + 4 * (pn - 9) + wc;
            base = KVH + (size_t)slot * M * 64; rstride = 64; }
        f32x4 gv[2][2], ks[2][2];
#pragma unroll
        for (int bj = 0; bj < 2; ++bj)
#pragma unroll
            for (int n = 0; n < 2; ++n) { gv[bj][n] = g ? *(const GAS f32x4*)(g + 32 * bj + 8 * fq + 4 * n) : (f32x4){1.f, 1.f, 1.f, 1.f}; ks[bj][n] = (f32x4){0.f, 0.f, 0.f, 0.f}; }
#pragma unroll
        for (int ai = 0; ai < 2; ++ai)
#pragma unroll
            for (int m = 0; m < 4; ++m) { const int row = row0 + ai * HALF + m * 16; const float r = rinv_get(R, u.pm, row & 255);
                f32x4 v[2][2]; f32x2e s2 = (f32x2e){0.f, 0.f};
#pragma unroll
                for (int bj = 0; bj < 2; ++bj)
#pragma unroll
                    for (int n = 0; n < 2; ++n) { const f32x4 a4 = acc[ai][bj][m][n]; const f32x2e lo = (f32x2e){a4[0], a4[1]}, hi = (f32x2e){a4[2], a4[3]}; s2 += lo * lo; s2 += hi * hi; }
                float sc = r;
                if (g) { float ss = (s2.x + s2.y) * (r * r); ss += swz_xor<16>(ss); ss = add_xor32(ss); sc = r * oscale / sqrtf(ss * (1.0f / 64.0f) + 1e-6f); }
#pragma unroll
                for (int bj = 0; bj < 2; ++bj)
#pragma unroll
                    for (int n = 0; n < 2; ++n) v[bj][n] = acc[ai][bj][m][n] * (gv[bj][n] * sc);
                if (kmean) {
#pragma unroll
                    for (int bj = 0; bj < 2; ++bj)
#pragma unroll
                        for (int n = 0; n < 2; ++n) ks[bj][n] += v[bj][n]; }
#pragma unroll
                for (int bj = 0; bj < 2; ++bj) *(GAS u32x4*)(base + (size_t)row * rstride + 32 * bj + 8 * fq) = pack8(v[bj][0], v[bj][1]);
                if (m & 1) asm volatile("" ::: "memory"); }
        if (kmean) {
            const int b = u.pm >> 3, nb = u.pm & 7; float* kd = KMS + (((size_t)b * 8 + hm) * 8 + nb) * 64;
#pragma unroll
            for (int bj = 0; bj < 2; ++bj)
#pragma unroll
                for (int n = 0; n < 2; ++n)
#pragma unroll
                    for (int i = 0; i < 4; ++i) { float s = ks[bj][n][i]; s += swz_xor<1>(s); s += swz_xor<2>(s); s += swz_xor<4>(s); s += swz_xor<8>(s);
                        if (fr == 0) __hip_atomic_fetch_add((GAS float*)(kd + 32 * bj + 8 * fq + 4 * n + i), s, __ATOMIC_RELAXED, __HIP_MEMORY_SCOPE_AGENT); }
        }
    }
};

struct Args { const float* in[14]; float* out; unsigned char* ws; int ph_lo, ph_hi, seq, prev_blocks; };
struct Frame {
    LAS unsigned char* lds; volatile LAS unsigned* MISC; gu32* ctl;
    int tid, lane, wave, vcu, G;
};


constexpr int CW_DONE = 8192;
__device__ __forceinline__ void launch_wait(gu32* ctl, int seq, int prev_blocks) {
    if (threadIdx.x == 0 && prev_blocks > 0) {
        unsigned sp = 0;
        while (__hip_atomic_load(ctl + CW_DONE + 64 * (seq - 1), __ATOMIC_RELAXED, __HIP_MEMORY_SCOPE_AGENT) < (unsigned)prev_blocks) { __builtin_amdgcn_s_sleep(2); if (++sp > (1u << 26)) break; }
        __builtin_amdgcn_fence(__ATOMIC_ACQUIRE, "agent"); asm volatile("s_waitcnt vmcnt(0)" ::: "memory");
    }
    __syncthreads();
}
__device__ __forceinline__ void launch_done(gu32* ctl, int seq) {
    asm volatile("s_waitcnt vmcnt(0)" ::: "memory"); __syncthreads();
    if (threadIdx.x == 0) { __builtin_amdgcn_fence(__ATOMIC_RELEASE, "agent"); asm volatile("s_waitcnt vmcnt(0)" ::: "memory");
        __hip_atomic_fetch_add(ctl + CW_DONE + 64 * seq, 1u, __ATOMIC_RELAXED, __HIP_MEMORY_SCOPE_AGENT); }
}
enum { MAP_ID = 0, MAP_GU = 1, MAP_HEAD = 2 };
struct Job { int src, soff, K, N, n0, nc, gsrc, goff, doff_kb  , Kd, kofs, map, mp; };
constexpr int NJOBS = 52;
struct JobTable { Job j[NJOBS]; int first[NJOBS + 1]; };
constexpr JobTable build_jobs() {
    JobTable T{}; int n = 0;
    for (int l = 0; l < 2; ++l) {
        for (int f = 0; f < 2; ++f) {
            const int nf = f == 0 ? 0 : 2, lf = l * 2 + f;
            T.j[n++] = Job{2, lf * DM * DFF, DM, DFF, 0, DFF, 1, (l * 3 + nf) * DM, (int)((WS_W13 + (size_t)lf * N13 * DM * 2) >> 10), DM, 0, MAP_GU, 0};
            T.j[n++] = Job{3, lf * DM * DFF, DM, DFF, 0, DFF, 1, (l * 3 + nf) * DM, (int)((WS_W13 + (size_t)lf * N13 * DM * 2) >> 10), DM, 0, MAP_GU, 128};
            T.j[n++] = Job{4, lf * DFF * DM, DFF, DM, 0, DM, -1, 0, (int)((WS_W2 + (size_t)lf * DM * DFF * 2) >> 10), DFF, 0, MAP_ID, 0};
        }
        const int so = l * DM * INC, go = (l * 3 + 1) * DM, dk = (int)((WS_WIN + (size_t)l * NIN * DM * 2) >> 10);
        T.j[n++] = Job{5, so, DM, INC, 0, 512, 1, go, dk, DM, 0, MAP_HEAD, 0};
        T.j[n++] = Job{5, so, DM, INC, 512, 128, 1, go, dk, DM, 0, MAP_HEAD, 8};
        T.j[n++] = Job{5, so, DM, INC, 640, 128, 1, go, dk, DM, 0, MAP_HEAD, 10};
        T.j[n++] = Job{5, so, DM, INC, 768, 128, 1, go, dk, DM, 0, MAP_HEAD, 12};
        T.j[n++] = Job{5, so, DM, INC, 896, 128, 1, go, dk, DM, 0, MAP_HEAD, 16};
        T.j[n++] = Job{5, so, DM, INC, 1024, 128, 1, go, dk, DM, 0, MAP_HEAD, 14};
        T.j[n++] = Job{5, so, DM, INC, 1152, 128, 1, go, dk, DM, 0, MAP_HEAD, 18};
        T.j[n++] = Job{5, so, DM, INC, 1280, 24, 1, go, dk, DM, 0, MAP_ID, 256 * 19};
        T.j[n++] = Job{5, so, DM, INC, 1304, 512, 1, go, dk, DM, 0, MAP_HEAD, 20};
        T.j[n++] = Job{5, so, DM, INC, 1816, 512, 1, go, dk, DM, 0, MAP_HEAD, 28};
        T.j[n++] = Job{5, so, DM, INC, 2328, 512, 1, go, dk, DM, 0, MAP_HEAD, 36};
        T.j[n++] = Job{5, so, DM, INC, 2840, 1024, 1, go, dk, DM, 0, MAP_ID, 256 * 11};
        T.j[n++] = Job{5, so, DM, INC, 3864, 1024, 1, go, dk, DM, 0, MAP_ID, 256 * 15};
        const int du = (int)((WS_WUP + (size_t)l * 2 * DM * 512 * 2) >> 10);
        T.j[n++] = Job{11, l * 512 * DM, 512, DM, 0, DM, -1, 0, du, DM, 0, MAP_ID, 0};
        T.j[n++] = Job{12, l * 512 * DM, 512, DM, 0, DM, -1, 0, du, DM, 512, MAP_ID, 0};
        T.j[n++] = Job{13, l * DM * DM, DM, DM, 0, DM, -1, 0, (int)((WS_WOUT + (size_t)l * DM * DM * 2) >> 10), DM, 0, MAP_ID, 0};
        for (int kv = 0; kv < 2; ++kv) {
            const int lk = l * 2 + kv;
            T.j[n++] = Job{9, lk * 2048 * 256, 2048, 256, 0, 256, -1, 0, (int)((WS_WC1 + (size_t)lk * 256 * 2048 * 2) >> 10), 2048, 0, MAP_ID, 0};
            T.j[n++] = Job{10, lk * 256 * 64, 256, 64, 0, 64, -1, 0, (int)((WS_WC2 + (size_t)lk * 256 * 256 * 2) >> 10), 256, 0, MAP_HEAD, 0};
        }
    }
    int tot = 0;
    for (int i = 0; i < NJOBS; ++i) { T.first[i] = tot; tot += (T.j[i].K / 64) * ((T.j[i].nc + 63) / 64); }
    T.first[NJOBS] = tot;
    return T;
}
__device__ const JobTable JT = build_jobs();
__device__ __forceinline__ int map_row(int map, int mp, int x) {
    if (map == MAP_ID) return mp + x;
    if (map == MAP_GU) return 256 * (x >> 7) + (x & 127) + mp;
    const int hs = mp + (x >> 6), d = x & 63; return 256 * (hs >> 2) + 128 * (d >> 5) + 32 * (hs & 3) + (d & 31);
}
struct TrItem { const float* W; const float* gain; bf16* dst; int N, k0, nsrc0, ncv, Kd, kofs, map, mp, x0; };
typedef float f32x2t __attribute__((ext_vector_type(2)));
__device__ __forceinline__ void tr_load(const TrItem& t, f32x2t (&v)[32], int lane) {
    const int c2 = lane & 31;
#pragma unroll
    for (int i = 0; i < 32; ++i) { const int kk = 2 * i + (lane >> 5); v[i] = (2 * c2 < t.ncv) ? *(const GAS f32x2t*)(t.W + (size_t)(t.k0 + kk) * t.N + t.nsrc0 + 2 * c2) : (f32x2t){0.f, 0.f}; }
}
__device__ __forceinline__ void tr_finish(const TrItem& t, const f32x2t (&v)[32], LAS float* scr, int lane) {
    const int c2 = lane & 31;
#pragma unroll
    for (int i = 0; i < 32; ++i) { const int kk = 2 * i + (lane >> 5); const float gg = t.gain ? t.gain[t.k0 + kk] : 1.0f; *(LAS f32x2t*)(scr + kk * 64 + ((2 * c2) ^ (kk & 62))) = v[i] * gg; }
    LDS_WAIT(); asm volatile("" ::: "memory");
    const int c8 = lane & 7;
#pragma unroll
    for (int j = 0; j < 8; ++j) { const int n = (lane >> 3) + 8 * j;
        float e[8];
#pragma unroll
        for (int q = 0; q < 8; ++q) { const int kk = 8 * c8 + q; e[q] = scr[kk * 64 + (n ^ (kk & 62))]; }
        v4u o; o.x = pg8::cvt_pk_bf16(e[0], e[1]); o.y = pg8::cvt_pk_bf16(e[2], e[3]); o.z = pg8::cvt_pk_bf16(e[4], e[5]); o.w = pg8::cvt_pk_bf16(e[6], e[7]);
        if (n < t.ncv) *(GAS v4u*)(t.dst + (size_t)map_row(t.map, t.mp, t.x0 + n) * t.Kd + t.kofs + t.k0 + 8 * c8) = o; }
    LDS_WAIT(); asm volatile("" ::: "memory");
}
__device__ __forceinline__ const float* in_ptr(const Args& a, int i) {
    const float* p = a.in[0];
    p = i == 1 ? a.in[1] : p; p = i == 2 ? a.in[2] : p; p = i == 3 ? a.in[3] : p; p = i == 4 ? a.in[4] : p; p = i == 5 ? a.in[5] : p; p = i == 9 ? a.in[9] : p;
    p = i == 10 ? a.in[10] : p; p = i == 11 ? a.in[11] : p; p = i == 12 ? a.in[12] : p; p = i == 13 ? a.in[13] : p; return p;
}
__device__ __forceinline__ float wave_sum(float v) {
    v += swz_xor<1>(v); v += swz_xor<2>(v); v += swz_xor<4>(v); v += swz_xor<8>(v); v += swz_xor<16>(v); v = add_xor32(v);
    return v;
}
__device__ __forceinline__ void p0_prologue(Frame& F, const Args& a) {
    LAS float* scr = (LAS float*)(F.lds + RING_OFF + F.wave * 16384);
    const int gw = F.vcu * NWAVES + F.wave, NGW = F.G * NWAVES;
    unsigned char* ws = a.ws;
    const int total = JT.first[NJOBS];
    LAS int* jt_l = (LAS int*)(F.lds + RING_OFF + 8 * 16384 - 4096);
    (void)jt_l;
    auto mk = [&](int it) { TrItem t;
        int ji = 0;
        for (int q = 1; q < NJOBS; ++q) ji = (it >= JT.first[q]) ? q : ji;
        const Job jb = JT.j[ji]; const int r = it - JT.first[ji];
        const int nblk = (jb.nc + 63) >> 6, kb = r / nblk, nb = r % nblk;
        t.W = in_ptr(a, jb.src) + jb.soff; t.N = jb.N; t.k0 = 64 * kb; t.nsrc0 = jb.n0 + 64 * nb; t.ncv = (jb.nc - 64 * nb) < 64 ? (jb.nc - 64 * nb) : 64;
        t.gain = jb.gsrc >= 0 ? a.in[1] + jb.goff : nullptr; t.dst = (bf16*)(ws + ((size_t)jb.doff_kb << 10)); t.Kd = jb.Kd; t.kofs = jb.kofs; t.map = jb.map; t.mp = jb.mp; t.x0 = 64 * nb;
        return t; };
    for (int it = gw; it < total; it += NGW) {
        const TrItem t0 = mk(it); f32x2t v0[32];
        tr_load(t0, v0, F.lane);
        tr_finish(t0, v0, scr, F.lane);
    }
    const int gt = F.vcu * (NWAVES * 64) + F.tid, GT = F.G * NWAVES * 64; const v4u z = {0u, 0u, 0u, 0u};
    for (int i = gt; i < 2 * 232 * 128; i += GT) { const int l = i / (232 * 128), r = i % (232 * 128); *(GAS v4u*)(ws + WS_WIN + (size_t)l * NIN * DM * 2 + (size_t)(19 * 256 + 24 + r / 128) * 2048 + (r % 128) * 16) = z; }
    for (int i = gt; i < 4 * 256 * 32; i += GT) { const int lk = i / (256 * 32), r = (i / 32) % 256, c = i % 32;
        if ((r & 127) >= 32) *(GAS v4u*)(ws + WS_WC2 + (size_t)lk * 256 * 256 * 2 + (size_t)r * 512 + c * 16) = z; }
    for (int i = gt; i < 2 * 16 * 8 * 8 * 64 / 4; i += GT) *(GAS v4u*)(ws + WS_KMS + (size_t)i * 16) = z;
    { const float* x = a.in[0]; bf16* xb = (bf16*)(ws + WS_XB); float* ssq = (float*)(ws + WS_SSQ);
      for (int m0 = 4 * gw; m0 < M; m0 += 4 * NGW) { f32x4 v[4][4];
#pragma unroll
          for (int rr = 0; rr < 4; ++rr) { const GAS f32x4* xr = (const GAS f32x4*)(x + (size_t)(m0 + rr) * DM) + F.lane;
#pragma unroll
              for (int j = 0; j < 4; ++j) v[rr][j] = xr[64 * j]; }
#pragma unroll
          for (int rr = 0; rr < 4; ++rr) { float s = 0.f;
#pragma unroll
              for (int j = 0; j < 4; ++j) s += dot4(v[rr][j]);
              s = wave_sum(s);
              GAS unsigned long long* o8 = (GAS unsigned long long*)(xb + (size_t)(m0 + rr) * DM) + F.lane;
#pragma unroll
              for (int j = 0; j < 4; ++j) o8[64 * j] = (unsigned long long)pg8::cvt_pk_bf16(v[rr][j][0], v[rr][j][1]) | ((unsigned long long)pg8::cvt_pk_bf16(v[rr][j][2], v[rr][j][3]) << 32);
              if (F.lane < 16) ssq[(size_t)(m0 + rr) * 16 + F.lane] = F.lane == 0 ? s : 0.f; } } }
    for (int w = blockIdx.x; w < 64; w += F.G) {
        const int lk = w >> 4, cg = w & 15, col = cg * 16 + (F.tid & 15), ks = F.tid >> 4;
        const float* pos = a.in[8] + (size_t)lk * 2048 + ks * 64; const float* w1 = a.in[9] + (size_t)lk * 2048 * 256 + (size_t)(ks * 64) * 256 + col;
        float s = 0.f;
#pragma unroll 16
        for (int k = 0; k < 64; ++k) s += pos[k] * w1[(size_t)k * 256];
        LAS float* red = (LAS float*)(F.lds + RING_OFF);
        __syncthreads();
        red[F.tid] = s;
        __syncthreads();
        if (F.tid < 16) { float t = 0.f;
#pragma unroll
            for (int q = 0; q < 32; ++q) t += red[q * 16 + F.tid];
            ((float*)(ws + WS_BC1))[lk * 256 + cg * 16 + F.tid] = t; }
        __syncthreads();
    }
}

__device__ __forceinline__ float dot64(const unsigned (&q)[32], const bf16* p) {
    float s0 = 0.f, s1 = 0.f;
#pragma unroll
    for (int c = 0; c < 8; ++c) { const u32x4 k = *(const GAS u32x4*)(p + 8 * c);
        s0 += bf_lo(q[4 * c]) * bf_lo(k.x); s1 += bf_hi(q[4 * c]) * bf_hi(k.x); s0 += bf_lo(q[4 * c + 1]) * bf_lo(k.y); s1 += bf_hi(q[4 * c + 1]) * bf_hi(k.y);
        s0 += bf_lo(q[4 * c + 2]) * bf_lo(k.z); s1 += bf_hi(q[4 * c + 2]) * bf_hi(k.z); s0 += bf_lo(q[4 * c + 3]) * bf_lo(k.w); s1 += bf_hi(q[4 * c + 3]) * bf_hi(k.w); }
    return s0 + s1;
}
__device__ __forceinline__ void axpy64(float (&o)[64], float p, const bf16* v) {
#pragma unroll
    for (int c = 0; c < 8; ++c) { const u32x4 k = *(const GAS u32x4*)(v + 8 * c);
        o[8 * c + 0] += p * bf_lo(k.x); o[8 * c + 1] += p * bf_hi(k.x); o[8 * c + 2] += p * bf_lo(k.y); o[8 * c + 3] += p * bf_hi(k.y);
        o[8 * c + 4] += p * bf_lo(k.z); o[8 * c + 5] += p * bf_hi(k.z); o[8 * c + 6] += p * bf_lo(k.w); o[8 * c + 7] += p * bf_hi(k.w); }
}
__device__ __forceinline__ void loadq(unsigned (&q)[32], const bf16* p) {
#pragma unroll
    for (int c = 0; c < 8; ++c) { const u32x4 k = *(const GAS u32x4*)(p + 8 * c); q[4 * c] = k.x; q[4 * c + 1] = k.y; q[4 * c + 2] = k.z; q[4 * c + 3] = k.w; }
}
__device__ __forceinline__ void store64(bf16* p, const float (&o)[64]) {
#pragma unroll
    for (int c = 0; c < 8; ++c) { u32x4 w; w.x = pk2(o[8 * c], o[8 * c + 1]); w.y = pk2(o[8 * c + 2], o[8 * c + 3]); w.z = pk2(o[8 * c + 4], o[8 * c + 5]); w.w = pk2(o[8 * c + 6], o[8 * c + 7]); *(GAS u32x4*)(p + 8 * c) = w; }
}
__global__ void __launch_bounds__(256) slow_moba_kernel(Args a, int l) {
    Frame F; F.tid = threadIdx.x; F.lane = F.tid & 63; F.G = gridDim.x;
    unsigned char* ws = a.ws;
    launch_wait((gu32*)(ws + WS_CTL), a.seq, a.prev_blocks);
    const bf16* Qm = (const bf16*)(ws + WS_QM); const bf16* KVH = (const bf16*)(ws + WS_KVH); bf16* OC = (bf16*)(ws + WS_XB);
    const float* KMS = (const float*)(ws + WS_KMS) + (size_t)l * 16 * 8 * 8 * 64;
    const int GT = F.G * 256;
    for (int base = blockIdx.x * 256; base < BATCH * 8 * SEQ; base += GT) {
        const int idx = base + F.tid, t = idx & 2047, h = (idx >> 11) & 7, b = idx >> 14, row = b * SEQ + t;
        unsigned q[32]; loadq(q, Qm + (size_t)row * 512 + 64 * h);
        const int cur = t >> 8;
        const float* km = KMS + ((size_t)b * 8 + h) * 8 * 64;
        float gate[8];
#pragma unroll
        for (int n = 0; n < 8; ++n) { float s = 0.f;
#pragma unroll
            for (int c = 0; c < 32; ++c) s += bf_lo(q[c]) * km[n * 64 + 2 * c] + bf_hi(q[c]) * km[n * 64 + 2 * c + 1];
            gate[n] = s; }
        unsigned sel = 0u;
#pragma unroll
        for (int k = 0; k < 3; ++k) { float best = -3.0e38f; int bi = -1;
#pragma unroll
            for (int n = 0; n < 8; ++n) { const bool ok = (n < cur) && !((sel >> n) & 1u) && gate[n] > best; best = ok ? gate[n] : best; bi = ok ? n : bi; }
            if (bi >= 0) sel |= 1u << bi; }
        const unsigned blocks = sel | (1u << cur);
        const float sl2 = exp2f(-(float)(h + 1)) * LOG2E;
        const bf16* Kh = KVH + ((size_t)(12 + h) * M + (size_t)b * SEQ) * 64; const bf16* Vh = KVH + ((size_t)(20 + h) * M + (size_t)b * SEQ) * 64;
        float lsum = 0.f; float o[64];
#pragma unroll
        for (int d = 0; d < 64; ++d) o[d] = 0.f;
        const int thi = t | 63;
        for (int n = 0; n <= cur; ++n) {
            const bool mine = (blocks >> n) & 1u;
            if (!__any(mine)) continue;
            const int shi = (256 * n + 255) < thi ? (256 * n + 255) : thi;
            for (int s = 256 * n; s <= shi; ++s) {
                const float sc = dot64(q, Kh + (size_t)s * 64) + sl2 * (float)(s - t);
                const float p = (mine && s <= t) ? exp2f(sc) : 0.f;
                lsum += p; axpy64(o, p, Vh + (size_t)s * 64);
            }
        }
        const float il = 1.0f / lsum;
#pragma unroll
        for (int d = 0; d < 64; ++d) o[d] *= il;
        store64(OC + (size_t)row * DM + 512 + 64 * h, o);
    }
    launch_done((gu32*)(ws + WS_CTL), a.seq);
}
__global__ void __launch_bounds__(256) slow_nsa_kernel(Args a, int l) {
    __shared__ float impS[64 * 33];
    Frame F; F.tid = threadIdx.x; F.lane = F.tid & 63; F.G = gridDim.x;
    unsigned char* ws = a.ws;
    launch_wait((gu32*)(ws + WS_CTL), a.seq, a.prev_blocks);
    const bf16* Qn = (const bf16*)(ws + WS_QN); const bf16* KVH = (const bf16*)(ws + WS_KVH); bf16* OC = (bf16*)(ws + WS_XB);
    const bf16* CK = (const bf16*)(ws + WS_CMP); const bf16* CV = CK + (size_t)4096 * 64; const float* GN = (const float*)(ws + WS_GN);
    float* impL = impS;
    const int GT = F.G * 256, tok = F.tid >> 2;
    for (int base = blockIdx.x * 256; base < BATCH * 2 * SEQ * 4; base += GT) {
        const int idx = base + F.tid, r = idx & 3, t = (idx >> 2) & 2047, g = (idx >> 13) & 1, b = idx >> 14, hn = 4 * g + r, row = b * SEQ + t;
        unsigned q[32]; loadq(q, Qn + (size_t)row * 512 + 64 * hn);
        const float sl2 = exp2f(-((float)hn + 0.5f)) * LOG2E;
        const float* gp = GN + (size_t)row * 24 + hn * 3; const float g0 = gp[0], g1 = gp[1], g2 = gp[2];
        const int thi = t | 15, cur = t >> 6;
        float ot[64], ob[64];
        const bf16* Kc = CK + ((size_t)(g * 16 + b) * 128) * 64; const bf16* Vc = CV + ((size_t)(g * 16 + b) * 128) * 64;
        const int ncv = t >= 31 ? ((t - 31) >> 4) + 1 : 0, ncw = thi >= 31 ? ((thi - 31) >> 4) + 1 : 0;
        float lc = 0.f;
#pragma unroll
        for (int d = 0; d < 64; ++d) ob[d] = 0.f;
        for (int c = 0; c < ncw; ++c) {
            const float sc = dot64(q, Kc + (size_t)c * 64) + sl2 * ((float)(16 * c) + 15.5f - (float)t);
            const float p = c < ncv ? exp2f(sc) : 0.f;
            lc += p; axpy64(ob, p, Vc + (size_t)c * 64);
        }
        const float ilc = lc > 0.f ? 1.0f / lc : 0.f;
#pragma unroll
        for (int d = 0; d < 64; ++d) ot[d] = ob[d] * (g0 * ilc);
        if (r == 0) { for (int j = 0; j < 33; ++j) impL[tok * 33 + j] = 0.f; }
        for (int c = 0; c < ncw; ++c) {
            const float sc = dot64(q, Kc + (size_t)c * 64) + sl2 * ((float)(16 * c) + 15.5f - (float)t);
            float p = c < ncv ? exp2f(sc) * ilc : 0.f;
            p += __shfl_xor(p, 1); p += __shfl_xor(p, 2);
            if (r == 0) { const int j = c >> 2; if ((c & 3) == 3) { impL[tok * 33 + j] += 0.5f * p; impL[tok * 33 + j + 1] += 0.5f * p; } else impL[tok * 33 + j] += p; }
        }
        __syncthreads();
        unsigned sel = 0u;
        for (int k = 0; k < 8; ++k) { float best = -3.0e38f; int bi = 0;
            for (int j = 0; j < 32; ++j) { const float s = (j == 0 || j == cur || j == cur - 1) ? 1.0e9f : (j <= cur ? impL[tok * 33 + j] : -1.0e30f);
                const bool ok = !((sel >> j) & 1u) && s > best; best = ok ? s : best; bi = ok ? j : bi; }
            sel |= 1u << bi; }
        __syncthreads();
        { const bf16* Ks = KVH + ((size_t)(4 + g) * M + (size_t)b * SEQ) * 64; const bf16* Vs = KVH + ((size_t)(8 + g) * M + (size_t)b * SEQ) * 64;
          float ls = 0.f;
#pragma unroll
          for (int d = 0; d < 64; ++d) ob[d] = 0.f;
          for (int j = 0; j <= cur; ++j) {
              const bool mine = (sel >> j) & 1u;
              if (!__any(mine)) continue;
              const int shi = (64 * j + 63) < thi ? (64 * j + 63) : thi;
              for (int s = 64 * j; s <= shi; ++s) {
                  const float sc = dot64(q, Ks + (size_t)s * 64) + sl2 * (float)(s - t);
                  const float p = (mine && s <= t) ? exp2f(sc) : 0.f;
                  ls += p; axpy64(ob, p, Vs + (size_t)s * 64);
              }
          }
          const float w = g1 / ls;
#pragma unroll
          for (int d = 0; d < 64; ++d) ot[d] += ob[d] * w; }
        { const bf16* Kw = KVH + ((size_t)(6 + g) * M + (size_t)b * SEQ) * 64; const bf16* Vw = KVH + ((size_t)(10 + g) * M + (size_t)b * SEQ) * 64;
          float lw = 0.f;
#pragma unroll
          for (int d = 0; d < 64; ++d) ob[d] = 0.f;
          const int slo = ((t & ~15) - 511) > 0 ? ((t & ~15) - 511) : 0;
          for (int s = slo; s <= thi; ++s) {
              const int dist = t - s;
              const float sc = dot64(q, Kw + (size_t)s * 64) - sl2 * (float)dist;
              const float p = (dist >= 0 && dist < 512) ? exp2f(sc) : 0.f;
              lw += p; axpy64(ob, p, Vw + (size_t)s * 64);
          }
          const float w = g2 / lw;
#pragma unroll
          for (int d = 0; d < 64; ++d) ot[d] += ob[d] * w; }
        store64(OC + (size_t)row * DM + 64 * hn, ot);
    }
    launch_done((gu32*)(ws + WS_CTL), a.seq);
}

namespace att {
typedef float f32x16 __attribute__((ext_vector_type(16)));
typedef short bf16x8 __attribute__((ext_vector_type(8)));
typedef short s16x4 __attribute__((ext_vector_type(4)));
constexpr int NBUF = 5, TILEB = 16384;
constexpr int L_RING = 0, L_WSCR = NBUF * TILEB, L_IMP = L_WSCR + 8 * 256, L_SELM = L_IMP + 64 * 32 * 4, L_WUN = L_SELM + 256, L_QSLOT = L_WUN + 32, L_KMEAN = L_WUN + 64,
              L_RAW = L_KMEAN + 8 * 64 * 4, L_ILV = L_RAW + 64 * 4 * 32 * 4, L_END = L_ILV + 64 * 4 * 4;
static_assert(L_END <= RING_BYTES, "attention LDS map");
constexpr float NEG_INF_F = -__builtin_huge_valf();

#define LDS_BARRIER() do { asm volatile("s_waitcnt lgkmcnt(0)" ::: "memory"); __builtin_amdgcn_s_barrier(); asm volatile("" ::: "memory"); } while (0)
struct Lane {
    int lane, r32, hi;
    int vb0, vb1;
    int kof[4];
    int dko, dvo;
};
__device__ __forceinline__ Lane make_lane(int lane, int wave) {
    Lane L; L.lane = lane; L.r32 = lane & 31; L.hi = lane >> 5;
    const int g1 = (lane >> 4) & 1, q = (lane & 15) >> 2, p = lane & 3, sw = (q >> 1) & 1;
    const int base = (4 * L.hi + q) * 128 + 32 * g1 + 8 * p;
    L.vb0 = base + 64 * sw; L.vb1 = base + 64 * (1 - sw);
#pragma unroll
    for (int d0 = 0; d0 < 4; ++d0) L.kof[d0] = L.r32 * 128 + (((2 * d0 + L.hi) ^ ((L.r32 >> 1) & 7)) << 4);
    const int row = 8 * wave + (lane >> 3), cp = lane & 7;
    L.dko = row * 64 + ((cp ^ ((row >> 1) & 7)) << 3); L.dvo = row * 64 + ((cp ^ (((row >> 1) & 1) << 2)) << 3);
    return L;
}
__device__ __forceinline__ void dma_tile(LAS unsigned char* buf, const bf16* Kt, const bf16* Vt, const Lane& L, int wave) {
    const unsigned lk = (unsigned)(size_t)(buf + wave * 1024), lv = lk + 8192u;
    const bf16* kp = Kt + L.dko; const bf16* vp = Vt + L.dvo;
    unsigned sv;
    asm volatile("s_mov_b32 %0, m0\n\ts_mov_b32 m0, %3\n\ts_nop 0\n\tglobal_load_lds_dwordx4 %1, off\n\ts_mov_b32 m0, %4\n\ts_nop 0\n\tglobal_load_lds_dwordx4 %2, off\n\ts_mov_b32 m0, %0"
                 : "=&s"(sv) : "v"(kp), "v"(vp), "s"(lk), "s"(lv) : "memory");
}
__device__ __forceinline__ void wait_tiles_ahead(int ahead) {
    if (ahead <= 0) asm volatile("s_waitcnt vmcnt(0)" ::: "memory");
    else if (ahead == 1) asm volatile("s_waitcnt vmcnt(2)" ::: "memory");
    else if (ahead == 2) asm volatile("s_waitcnt vmcnt(4)" ::: "memory");
    else if (ahead == 3) asm volatile("s_waitcnt vmcnt(6)" ::: "memory");
    else asm volatile("s_waitcnt vmcnt(8)" ::: "memory");
}
__device__ __forceinline__ unsigned cvtpk(float lo, float hi) { return pg8::cvt_pk_bf16(lo, hi); }
#ifndef TS_BATCH
#define TS_BATCH 0
#endif
#ifndef MOBA_BATCH
#define MOBA_BATCH 1
#endif
#ifndef NSA_BATCH
#define NSA_BATCH 0
#endif
#ifndef TS_UNPACK
#define TS_UNPACK 1
#endif
#if TS_UNPACK
#define TS_PIN(v) asm volatile("" : "+v"(v))
#else
#define TS_PIN(v) do {} while (0)
#endif
template <bool LEAN = false, bool BATCH = (TS_BATCH != 0)>
__device__ __forceinline__ void tile_step(LAS const unsigned char* kb, LAS const unsigned char* vb, const bf16x8 (&qf)[4], const Lane& L, float slopeK, float x,
                                          bool need_causal, int kq, bool need_win, int kwin, int jbase, f32x16 (&o)[2], float& l, f32x16& p0, f32x16& p1) {
#pragma unroll
    for (int r = 0; r < 16; ++r) { const float kc = (float)((r & 3) + 8 * (r >> 2)); float a = __builtin_fmaf(slopeK, kc, x); TS_PIN(a); p0[r] = a; float b = __builtin_fmaf(slopeK, kc + 32.0f, x); TS_PIN(b); p1[r] = b; }
if constexpr (BATCH) {
    bf16x8 kf0[4], kf1[4];
#pragma unroll
    for (int d0 = 0; d0 < 4; ++d0) kf0[d0] = *(LAS const bf16x8*)(kb + L.kof[d0]);
    if constexpr (!LEAN) {
#pragma unroll
        for (int d0 = 0; d0 < 4; ++d0) kf1[d0] = *(LAS const bf16x8*)(kb + 4096 + L.kof[d0]); }
#pragma unroll
    for (int d0 = 0; d0 < 4; ++d0) p0 = __builtin_amdgcn_mfma_f32_32x32x16_bf16(kf0[d0], qf[d0], p0, 0, 0, 0);
    if constexpr (LEAN) {
        __builtin_amdgcn_sched_barrier(0);
#pragma unroll
        for (int d0 = 0; d0 < 4; ++d0) kf1[d0] = *(LAS const bf16x8*)(kb + 4096 + L.kof[d0]); }
#pragma unroll
    for (int d0 = 0; d0 < 4; ++d0) p1 = __builtin_amdgcn_mfma_f32_32x32x16_bf16(kf1[d0], qf[d0], p1, 0, 0, 0);
} else {
#pragma unroll
    for (int d0 = 0; d0 < 4; ++d0) { const bf16x8 k0 = *(LAS const bf16x8*)(kb + L.kof[d0]); p0 = __builtin_amdgcn_mfma_f32_32x32x16_bf16(k0, qf[d0], p0, 0, 0, 0); }
#pragma unroll
    for (int d0 = 0; d0 < 4; ++d0) { const bf16x8 k1 = *(LAS const bf16x8*)(kb + 4096 + L.kof[d0]); p1 = __builtin_amdgcn_mfma_f32_32x32x16_bf16(k1, qf[d0], p1, 0, 0, 0); }
}
    float ssum = 0.f;
#pragma unroll
    for (int u = 0; u < 2; ++u) {
        f32x16& p = u ? p1 : p0;
        bf16x8 vf[2][2];
if constexpr (BATCH) {
#pragma unroll
        for (int s = 0; s < (LEAN ? 1 : 2); ++s)
#pragma unroll
            for (int db = 0; db < 2; ++db) { LAS const unsigned char* va = vb + (db ? L.vb1 : L.vb0) + (32 * u + 16 * s) * 128;
                const s16x4 lo = __builtin_bit_cast(s16x4, __builtin_amdgcn_ds_read_tr16_b64_v4i16((LAS s16x4*)(va)));
                const s16x4 hh = __builtin_bit_cast(s16x4, __builtin_amdgcn_ds_read_tr16_b64_v4i16((LAS s16x4*)(va + 8 * 128)));
                vf[s][db] = (bf16x8){lo[0], lo[1], lo[2], lo[3], hh[0], hh[1], hh[2], hh[3]}; }
}
        const int kb0 = jbase + 32 * u + 4 * L.hi;
        if (need_causal) {
#pragma unroll
            for (int r = 0; r < 16; ++r) { const int kv = kb0 + (r & 3) + 8 * (r >> 2); p[r] = kv > kq ? NEG_INF_F : p[r]; } }
        if (need_win) {
#pragma unroll
            for (int r = 0; r < 16; ++r) { const int kv = kb0 + (r & 3) + 8 * (r >> 2); p[r] = kv <= kwin ? NEG_INF_F : p[r]; } }
        float s0 = 0.f, s1 = 0.f;
#pragma unroll
        for (int r = 0; r < 16; r += 2) { const float e0 = __builtin_amdgcn_exp2f(p[r]), e1 = __builtin_amdgcn_exp2f(p[r + 1]); p[r] = e0; p[r + 1] = e1; s0 += e0; TS_PIN(s0); s1 += e1; TS_PIN(s1); }
        ssum += s0 + s1;
        unsigned pw[8];
#pragma unroll
        for (int i = 0; i < 8; ++i) pw[i] = cvtpk(p[2 * i], p[2 * i + 1]);
#pragma unroll
        for (int s = 0; s < 2; ++s) {
            u32x4 pa; pa.x = pw[4 * s]; pa.y = pw[4 * s + 1]; pa.z = pw[4 * s + 2]; pa.w = pw[4 * s + 3];
            const bf16x8 af = __builtin_bit_cast(bf16x8, pa);
if constexpr (BATCH) {
#pragma unroll
            for (int db = 0; db < 2; ++db) o[db] = __builtin_amdgcn_mfma_f32_32x32x16_bf16(af, vf[LEAN ? 0 : s][db], o[db], 0, 0, 0);
            if constexpr (LEAN) { if (s == 0) {
#pragma unroll
                for (int db = 0; db < 2; ++db) { LAS const unsigned char* va = vb + (db ? L.vb1 : L.vb0) + (32 * u + 16) * 128;
                    const s16x4 lo = __builtin_bit_cast(s16x4, __builtin_amdgcn_ds_read_tr16_b64_v4i16((LAS s16x4*)(va)));
                    const s16x4 hh = __builtin_bit_cast(s16x4, __builtin_amdgcn_ds_read_tr16_b64_v4i16((LAS s16x4*)(va + 8 * 128)));
                    vf[0][db] = (bf16x8){lo[0], lo[1], lo[2], lo[3], hh[0], hh[1], hh[2], hh[3]}; } } }
} else {
            const int roff = (32 * u + 16 * s) * 128;
#pragma unroll
            for (int db = 0; db < 2; ++db) { LAS const unsigned char* va = vb + (db ? L.vb1 : L.vb0) + roff;
                const s16x4 lo = __builtin_bit_cast(s16x4, __builtin_amdgcn_ds_read_tr16_b64_v4i16((LAS s16x4*)(va)));
                const s16x4 hh = __builtin_bit_cast(s16x4, __builtin_amdgcn_ds_read_tr16_b64_v4i16((LAS s16x4*)(va + 8 * 128)));
                const bf16x8 bfv = (bf16x8){lo[0], lo[1], lo[2], lo[3], hh[0], hh[1], hh[2], hh[3]};
                o[db] = __builtin_amdgcn_mfma_f32_32x32x16_bf16(af, bfv, o[db], 0, 0, 0); }
}
        }
    }
    l += ssum;
}
struct Ring { unsigned mi, mc, mi2, mc2; int issued, computed, ib, cb; };
__device__ __forceinline__ void ring_init(Ring& R, unsigned firstmask, int b0 = 0) { R.mi = R.mc = firstmask; R.mi2 = R.mc2 = 0u; R.issued = R.computed = 0; R.ib = R.cb = b0; }
__device__ __forceinline__ bool ring_issue(Ring& R, LAS unsigned char* lds, const bf16* Kb, const bf16* Vb, const bf16* Kb2, const bf16* Vb2, const Lane& L, int wave) {
    const bool first = R.mi != 0u;
    unsigned& m = first ? R.mi : R.mi2;
    if (m == 0u) return false;
    const int jn = __builtin_ctz(m); m &= m - 1u;
    dma_tile(lds + L_RING + R.ib * TILEB, (first ? Kb : Kb2) + (size_t)jn * 4096, (first ? Vb : Vb2) + (size_t)jn * 4096, L, wave); ++R.issued; R.ib = (R.ib + 1 == NBUF) ? 0 : R.ib + 1;
    return true;
}
#ifndef PAIRS
#define PAIRS 1
#endif
#if PAIRS
template <bool MOBA, bool WIN, int PART>
__device__ __forceinline__ void attn_consume(Ring& R, LAS unsigned char* lds, int wave, const bf16* Kb, const bf16* Vb, const bf16* Kb2, const bf16* Vb2, unsigned rowmask, const bf16x8 (&qf)[4], const Lane& L,
                                             float slopeK, float xconst, int kq, int kq_min, int kq_max, int kwin, int kwin_max, f32x16 (&o)[2], float& l) {
    if (PART != 2) {
#pragma unroll 1
        while (R.issued - R.computed < NBUF - 1) { if (!ring_issue(R, lds, Kb, Vb, Kb2, Vb2, L, wave)) break; } }
    f32x16 p0, p1;
#pragma unroll 1
    while (PART == 1 ? R.mc : (R.mc | R.mc2)) {
        int jj[2]; int cnt = 0;
#pragma unroll
        for (int t = 0; t < 2; ++t) { if (PART == 1 ? R.mc : (R.mc | R.mc2)) { unsigned& m = (PART == 1 || R.mc) ? R.mc : R.mc2; jj[t] = __builtin_ctz(m); m &= m - 1u; ++cnt; } else jj[t] = 0; }
        wait_tiles_ahead(R.issued - R.computed - cnt);
        LDS_BARRIER();
#pragma unroll 1
        while (R.issued - R.computed < NBUF) { if (!ring_issue(R, lds, Kb, Vb, Kb2, Vb2, L, wave)) break; }
#pragma unroll 1
        for (int t = 0; t < cnt; ++t) {
            const int j = t ? jj[1] : jj[0];
            const int jbase = 64 * j;
            const bool en = (rowmask >> (MOBA ? (j >> 2) : j)) & 1u;
            if (jbase <= kq_max && __ballot(en) != 0ull) {
                const float x = en ? __builtin_fmaf(slopeK, (float)(jbase + 4 * L.hi), xconst) : NEG_INF_F;
                int cbt = R.cb + t; cbt = cbt >= NBUF ? cbt - NBUF : cbt;
                LAS const unsigned char* tb = lds + L_RING + cbt * TILEB;
                tile_step<WIN, (MOBA ? (MOBA_BATCH != 0) : (NSA_BATCH != 0))>(tb, tb + 8192, qf, L, slopeK, x, (jbase + 63) > kq_min, kq, WIN && (jbase <= kwin_max), kwin, jbase, o, l, p0, p1);
            }
        }
        R.computed += cnt; R.cb += cnt; R.cb = R.cb >= NBUF ? R.cb - NBUF : R.cb;
    }
    if (PART != 1) LDS_BARRIER();
}
#endif
__device__ __forceinline__ void row_scales(LAS float* wscr, const Lane& L, float sc, float (&out)[16]) {
    if (L.hi == 0) wscr[L.r32] = sc;
    asm volatile("s_waitcnt lgkmcnt(0)" ::: "memory");
#pragma unroll
    for (int r = 0; r < 16; ++r) out[r] = wscr[(r & 3) + 8 * (r >> 2) + 4 * L.hi];
    asm volatile("s_waitcnt lgkmcnt(0)" ::: "memory");
}
__device__ __forceinline__ void load_q(bf16x8 (&qf)[4], const bf16* qrow, int hi) {
#pragma unroll
    for (int d0 = 0; d0 < 4; ++d0) qf[d0] = *(const GAS bf16x8*)(qrow + 16 * d0 + 8 * hi);
}

__device__ __forceinline__ void moba_unit(LAS unsigned char* lds, int tid_unused, int wave, int b, int h, int n, const bf16* Qm, const bf16* KVH, const float* KMS, bf16* OC) {
    int lane_v; asm volatile("v_mbcnt_lo_u32_b32 %0, -1, 0\n\tv_mbcnt_hi_u32_b32 %0, -1, %0" : "=v"(lane_v));
    const int tid = wave * 64 + lane_v; (void)tid_unused;
    const Lane L = make_lane(lane_v, wave);
    const int t_q = 256 * n + 32 * wave + L.r32, row = b * SEQ + t_q;
    const bf16* Kh = KVH + ((size_t)(12 + h) * M + (size_t)b * SEQ) * 64; const bf16* Vh = KVH + ((size_t)(20 + h) * M + (size_t)b * SEQ) * 64;
    bf16x8 qf[4]; load_q(qf, Qm + (size_t)row * 512 + 64 * h, L.hi);
    const float kmv = *(const GAS float*)(KMS + ((size_t)b * 8 + h) * 8 * 64 + tid);
    Ring R; ring_init(R, 0xFu << (4 * n));
#pragma unroll 1
    for (int k = 0; k < NBUF - 1; ++k) (void)ring_issue(R, lds, Kh, Vh, Kh, Vh, L, wave);
    LAS float* km = (LAS float*)(lds + L_KMEAN);
    km[tid] = kmv;
    LDS_BARRIER();
    unsigned blocks = 0u;
    { float gate[8];
#pragma unroll
      for (int nb = 0; nb < 8; ++nb) { float s = 0.f;
#pragma unroll
          for (int d0 = 0; d0 < 4; ++d0) { const u32x4 qq = __builtin_bit_cast(u32x4, qf[d0]); const LAS float* kp = km + nb * 64 + 16 * d0 + 8 * L.hi;
              s += bf_lo(qq.x) * kp[0] + bf_hi(qq.x) * kp[1] + bf_lo(qq.y) * kp[2] + bf_hi(qq.y) * kp[3] + bf_lo(qq.z) * kp[4] + bf_hi(qq.z) * kp[5] + bf_lo(qq.w) * kp[6] + bf_hi(qq.w) * kp[7]; }
          s = add_xor32(s); gate[nb] = s; }
      unsigned sel = 0u;
#pragma unroll
      for (int k = 0; k < 3; ++k) { float best = -3.0e38f; int bi = -1;
#pragma unroll
          for (int nb = 0; nb < 8; ++nb) { const bool ok = (nb < n) && !((sel >> nb) & 1u) && gate[nb] > best; best = ok ? gate[nb] : best; bi = ok ? nb : bi; }
          if (bi >= 0) sel |= 1u << bi; }
      blocks = sel | (1u << n); }
    unsigned wun = 0u;
#pragma unroll
    for (int nb = 0; nb < 8; ++nb) wun |= (__ballot((blocks >> nb) & 1u) != 0ull) ? (1u << nb) : 0u;
    LAS unsigned* wu = (LAS unsigned*)(lds + L_WUN);
    if ((tid & 63) == 0) wu[wave] = wun;
    LDS_BARRIER();
    unsigned un = 0u;
#pragma unroll
    for (int w = 0; w < 8; ++w) un |= wu[w];
    unsigned pastmask = 0u;
#pragma unroll
    for (int nb = 0; nb < 8; ++nb) pastmask |= (((un >> nb) & 1u) && nb != n) ? (0xFu << (4 * nb)) : 0u;
    R.mi2 = R.mc2 = pastmask;
    const float slope2 = __builtin_amdgcn_exp2f(-(float)(h + 1)) * LOG2E;
    const int tmin = 256 * n + 32 * wave, tmax = tmin + 31;
    f32x16 o[2]; o[0] = (f32x16){}; o[1] = (f32x16){}; float lsum = 0.f;
    attn_consume<true, false, 0>(R, lds, wave, Kh, Vh, Kh, Vh, blocks, qf, L, slope2, -slope2 * (float)t_q, t_q, tmin, tmax, 0, 0, o, lsum);
    lsum = add_xor32(lsum);
    float sc[16]; row_scales((LAS float*)(lds + L_WSCR + wave * 256), L, 1.0f / lsum, sc);
    { LAS unsigned short* stg = (LAS unsigned short*)(lds + L_RING + wave * 4096);
      int lo_ = L.r32; asm volatile("" : "+v"(lo_));
#pragma unroll
      for (int r = 0; r < 16; ++r) { const int q = (r & 3) + 8 * (r >> 2) + 4 * L.hi;
          stg[q * 64 + lo_] = (unsigned short)(pg8::cvt_pk_bf16(o[0][r] * sc[r], 0.f) & 0xffffu); stg[q * 64 + 32 + lo_] = (unsigned short)(pg8::cvt_pk_bf16(o[1][r] * sc[r], 0.f) & 0xffffu); }
      asm volatile("s_waitcnt lgkmcnt(0)" ::: "memory");
      bf16* ob = OC + (size_t)(b * SEQ + 256 * n + 32 * wave) * DM + 512 + 64 * h;
#pragma unroll
      for (int i = 0; i < 4; ++i) { const int row = 8 * i + (L.lane >> 3), ch = L.lane & 7;
          const u32x4 v = *(LAS const u32x4*)((LAS const unsigned char*)stg + i * 1024 + L.lane * 16);
          *(GAS u32x4*)(ob + (size_t)row * DM + 8 * ch) = v; } }
    LDS_BARRIER();
}
__device__ __forceinline__ int queue_first(LAS unsigned char* lds, unsigned* counter, bool lane0) {
    LAS int* slot = (LAS int*)(lds + L_QSLOT);
    if (lane0) *slot = (int)__hip_atomic_fetch_add((GAS unsigned*)counter, 1u, __ATOMIC_RELAXED, __HIP_MEMORY_SCOPE_AGENT);
    __syncthreads();
    const int u = *slot;
    __syncthreads();
    return u;
}
__device__ __forceinline__ int queue_request(unsigned* counter, bool lane0) { int r = 0; if (lane0) r = (int)__hip_atomic_fetch_add((GAS unsigned*)counter, 1u, __ATOMIC_RELAXED, __HIP_MEMORY_SCOPE_AGENT); return r; }
__device__ __forceinline__ int queue_publish(LAS unsigned char* lds, int r, bool lane0) {
    LAS int* slot = (LAS int*)(lds + L_QSLOT);
    if (lane0) *slot = r;
    LDS_BARRIER();
    const int u = *slot;
    LDS_BARRIER();
    return u;
}
__device__ __forceinline__ void moba_phase(LAS unsigned char* lds, int tid, int wave, int vcu, int G, unsigned char* ws, int l, bf16* OC, int qidx) {
    const bf16* Qm = (const bf16*)(ws + WS_QM); const bf16* KVH = (const bf16*)(ws + WS_KVH);
    const float* KMS = (const float*)(ws + WS_KMS) + (size_t)l * 16 * 8 * 8 * 64;
    unsigned* counter = (unsigned*)(ws + WS_CTL) + CW_QUEUE + 64 * qidx;
    (void)vcu; (void)G;
    int u = queue_first(lds, counter, tid == 0);
    while (u < 1024) {
        const int nxt = queue_request(counter, tid == 0);
        const int n = 7 - (u >> 7), bh = u & 127;
        moba_unit(lds, tid, wave, bh >> 3, bh & 7, n, Qm, KVH, KMS, OC);
        u = queue_publish(lds, nxt, tid == 0);
    }
}

__device__ __forceinline__ void nsa_unit(LAS unsigned char* lds, int tid_unused, int wave, int b, int g, int cur, const bf16* Qn, const bf16* KVH, const bf16* CK, const bf16* CV, const float* GN, bf16* OC) {
    int lane_v; asm volatile("v_mbcnt_lo_u32_b32 %0, -1, 0\n\tv_mbcnt_hi_u32_b32 %0, -1, %0" : "=v"(lane_v));
    const int tid = wave * 64 + lane_v; (void)tid_unused;
    const Lane L = make_lane(lane_v, wave);
    const int t0 = 64 * cur, tl = L.r32 >> 2, hd = L.r32 & 3, hn = 4 * g + hd;
    const int t_q = t0 + 8 * wave + tl, row = b * SEQ + t_q;
    bf16x8 qf[4]; load_q(qf, Qn + (size_t)row * 512 + 64 * hn, L.hi);
    const GAS float* gp = (const GAS float*)(GN + (size_t)row * 24 + hn * 3); const float g0 = gp[0], g1 = gp[1], g2 = gp[2];
    const float slope2 = __builtin_amdgcn_exp2f(-((float)hn + 0.5f)) * LOG2E;
    LAS float* wscr = (LAS float*)(lds + L_WSCR + wave * 256);
    f32x16 ot[2]; ot[0] = (f32x16){}; ot[1] = (f32x16){};
    f32x16 o[2]; float lsum; float sc[16];
    const int tmin = t0 + 8 * wave, tmax = tmin + 7;
    unsigned rowmask;
    const unsigned causal_tiles = (cur >= 31) ? 0xFFFFFFFFu : ((2u << cur) - 1u);
    const bf16* Ks = KVH + ((size_t)(4 + g) * M + (size_t)b * SEQ) * 64; const bf16* Vs = KVH + ((size_t)(8 + g) * M + (size_t)b * SEQ) * 64;
    const bf16* Kw = KVH + ((size_t)(6 + g) * M + (size_t)b * SEQ) * 64; const bf16* Vw = KVH + ((size_t)(10 + g) * M + (size_t)b * SEQ) * 64;
    Ring R;
    {
        const int cq = (t_q - 31) >> 4;
        const int cq_min = (tmin - 31) >> 4, cq_max = (tmax - 31) >> 4;
        const int maxc = (t0 + 63 - 31) >> 4;
        const int ntile = (maxc >> 6) + 1;
        const float slopeK = 16.0f * slope2, xconst = slope2 * (15.5f - (float)t_q);
        const bf16* Kc = CK + ((size_t)(g * 16 + b) * 128) * 64; const bf16* Vc = CV + ((size_t)(g * 16 + b) * 128) * 64;
        o[0] = (f32x16){}; o[1] = (f32x16){}; lsum = 0.f;
        LAS float* raw = (LAS float*)(lds + L_RAW);
        LAS float* ilv = (LAS float*)(lds + L_ILV);
        const int ts = 8 * wave + tl;
        LAS float* rawp = raw + (ts * 4 + hd) * 32;
        dma_tile(lds + L_RING, Kc, Vc, L, wave);
        if (ntile > 1) dma_tile(lds + L_RING + TILEB, Kc + 4096, Vc + 4096, L, wave);
        ring_init(R, ((cur >= 8) ? (0x1FFu << (cur - 8)) : causal_tiles) & causal_tiles, 2);
#pragma unroll 1
        for (int k = 0; k < 3; ++k) (void)ring_issue(R, lds, Kw, Vw, Ks, Vs, L, wave);
        wait_tiles_ahead(R.issued);
        LDS_BARRIER();
        float carry = 0.f;
#pragma unroll
        for (int i = 0; i < 2; ++i) {
            if (i < ntile) {
                f32x16 p0, p1;
                const float x = __builtin_fmaf(slopeK, (float)(64 * i + 4 * L.hi), xconst);
                tile_step<false, (NSA_BATCH != 0)>(lds + L_RING + i * TILEB, lds + L_RING + i * TILEB + 8192, qf, L, slopeK, x, true, cq, false, 0, 64 * i, o, lsum, p0, p1);
                float Bprev = carry;
#pragma unroll
                for (int k2 = 0; k2 < 8; ++k2) {
                    const float q0 = k2 < 4 ? p0[4 * k2] : p1[4 * (k2 - 4)], q1 = k2 < 4 ? p0[4 * k2 + 1] : p1[4 * (k2 - 4) + 1], q2 = k2 < 4 ? p0[4 * k2 + 2] : p1[4 * (k2 - 4) + 2], q3 = k2 < 4 ? p0[4 * k2 + 3] : p1[4 * (k2 - 4) + 3];
                    const float Bq = 0.5f * q3, pB = get_xor32(Bq, L.hi);
                    const float add = L.hi ? pB : Bprev;
                    rawp[16 * i + 2 * k2 + L.hi] = (q0 + q1) + (q2 + Bq) + add;
                    Bprev = pB;
                }
                carry = Bprev;
            }
        }
        (void)cq_min; (void)cq_max;
        lsum = add_xor32(lsum);
        const float il = lsum > 0.f ? 1.0f / lsum : 0.f;
        if (L.hi == 0) ilv[ts * 4 + hd] = il;
        row_scales(wscr, L, g0 * il, sc);
#pragma unroll
        for (int r = 0; r < 16; ++r) { ot[0][r] = o[0][r] * sc[r]; ot[1][r] = o[1][r] * sc[r]; }
        asm volatile("s_waitcnt lgkmcnt(0)" ::: "memory");
        LAS float* imp = (LAS float*)(lds + L_IMP);
#pragma unroll 1
        for (int pass = 0; pass < 4; ++pass) {
            const int tsp = 8 * wave + 2 * pass + (L.lane >> 5), jj = L.lane & 31;
            float v = 0.f;
#pragma unroll
            for (int hh = 0; hh < 4; ++hh) v += raw[(tsp * 4 + hh) * 32 + jj] * ilv[tsp * 4 + hh];
            imp[tsp * 32 + jj] = (jj == 0 || jj == cur || jj == cur - 1) ? 1.0e9f : (jj <= cur ? v : -1.0e30f);
        }
        asm volatile("s_waitcnt lgkmcnt(0)" ::: "memory");
        unsigned wun = 0u;
        LAS unsigned* selm = (LAS unsigned*)(lds + L_SELM);
#pragma unroll 1
        for (int pass = 0; pass < 4; ++pass) {
            const int tsp = 8 * wave + 2 * pass + (L.lane >> 5), jj = L.lane & 31;
            const LAS float* rowp = imp + tsp * 32;
            const float my = rowp[jj]; int rank = 0;
#pragma unroll
            for (int j4 = 0; j4 < 8; ++j4) { const f32x4 vv = *(const LAS f32x4*)(rowp + 4 * j4);
#pragma unroll
                for (int e = 0; e < 4; ++e) { const int jo = 4 * j4 + e; rank += (vv[e] > my || (vv[e] == my && jo < jj)) ? 1 : 0; } }
            const unsigned long long bal = __ballot(rank < 8);
            const unsigned lo = (unsigned)bal, hi32 = (unsigned)(bal >> 32);
            if (L.lane == 0) { selm[8 * wave + 2 * pass] = lo; selm[8 * wave + 2 * pass + 1] = hi32; }
            wun |= lo | hi32;
        }
        LAS unsigned* wu = (LAS unsigned*)(lds + L_WUN);
        if (L.lane == 0) wu[wave] = wun;
        __syncthreads();
        rowmask = selm[ts];
    }
    unsigned un = 0u;
    { LAS unsigned* wu = (LAS unsigned*)(lds + L_WUN);
#pragma unroll
      for (int w = 0; w < 8; ++w) un |= wu[w]; }
    R.mi2 = R.mc2 = un & causal_tiles;
    o[0] = (f32x16){}; o[1] = (f32x16){}; lsum = 0.f;
    LAS float* stash = (LAS float*)(lds + RINV_OFF) + tid;
#pragma unroll
    for (int k = 0; k < 7; ++k) stash[k * 512] = ot[1][9 + k];
    attn_consume<false, true, 1>(R, lds, wave, Kw, Vw, Ks, Vs, 0xFFFFFFFFu, qf, L, slope2, -slope2 * (float)t_q, t_q, tmin, tmax, t_q - 512, tmax - 512, o, lsum);
    lsum = add_xor32(lsum);
#pragma unroll
    for (int k = 0; k < 7; ++k) ot[1][9 + k] = stash[k * 512];
    row_scales(wscr, L, g2 / lsum, sc);
#pragma unroll
    for (int r = 0; r < 16; ++r) { ot[0][r] += o[0][r] * sc[r]; ot[1][r] += o[1][r] * sc[r]; }
    o[0] = (f32x16){}; o[1] = (f32x16){}; lsum = 0.f;
    attn_consume<false, false, 2>(R, lds, wave, Kw, Vw, Ks, Vs, rowmask, qf, L, slope2, -slope2 * (float)t_q, t_q, tmin, tmax, 0, 0, o, lsum);
    lsum = add_xor32(lsum);
    row_scales(wscr, L, g1 / lsum, sc);
#pragma unroll
    for (int r = 0; r < 16; ++r) { ot[0][r] += o[0][r] * sc[r]; ot[1][r] += o[1][r] * sc[r]; }
    { LAS unsigned short* stg = (LAS unsigned short*)(lds + L_RING + wave * 4096);
      int lo_ = L.r32; asm volatile("" : "+v"(lo_));
#pragma unroll
      for (int r = 0; r < 16; ++r) { const int q = (r & 3) + 8 * (r >> 2) + 4 * L.hi; const int so = (q >> 2) * 256 + (q & 3) * 64;
          stg[so + lo_] = (unsigned short)(pg8::cvt_pk_bf16(ot[0][r], 0.f) & 0xffffu); stg[so + 32 + lo_] = (unsigned short)(pg8::cvt_pk_bf16(ot[1][r], 0.f) & 0xffffu); }
      asm volatile("s_waitcnt lgkmcnt(0)" ::: "memory");
      bf16* ob = OC + (size_t)(b * SEQ + t0 + 8 * wave) * DM + 256 * g;
#pragma unroll
      for (int i = 0; i < 4; ++i) { const int tok = 2 * i + (L.lane >> 5), cb8 = L.lane & 31;
          const u32x4 v = *(LAS const u32x4*)((LAS const unsigned char*)stg + i * 1024 + L.lane * 16);
          *(GAS u32x4*)(ob + (size_t)tok * DM + 8 * cb8) = v; } }
    LDS_BARRIER();
}
__device__ __forceinline__ void nsa_phase(LAS unsigned char* lds, int tid, int wave, int vcu, int G, unsigned char* ws, int l, bf16* OC, int qidx) {
    const bf16* Qn = (const bf16*)(ws + WS_QN); const bf16* KVH = (const bf16*)(ws + WS_KVH);
    const bf16* CK = (const bf16*)(ws + WS_CMP); const bf16* CV = CK + (size_t)4096 * 64; const float* GN = (const float*)(ws + WS_GN);
    unsigned* counter = (unsigned*)(ws + WS_CTL) + CW_QUEUE + 64 * qidx;
    (void)vcu; (void)G;
    int u = queue_first(lds, counter, tid == 0);
    while (u < 1024) {
        const int nxt = queue_request(counter, tid == 0);
        const int cur = 31 - (u >> 5), bg = u & 31;
        nsa_unit(lds, tid, wave, bg >> 1, bg & 1, cur, Qn, KVH, CK, CV, GN, OC);
        u = queue_publish(lds, nxt, tid == 0);
    }
}
}

typedef const char __attribute__((address_space(4))) kconst_char;
__device__ __forceinline__ unsigned char* ws_reload() {
    kconst_char* ka = (kconst_char*)__builtin_amdgcn_kernarg_segment_ptr();
    return (unsigned char*)(*(const volatile unsigned long long __attribute__((address_space(4)))*)(ka + 120));
}
template <class T> __device__ __forceinline__ T* opq_ptr(T* p) { const unsigned long long v = (unsigned long long)p; unsigned lo = __builtin_amdgcn_readfirstlane((unsigned)v), hi = __builtin_amdgcn_readfirstlane((unsigned)(v >> 32)); asm volatile("" : "+s"(lo), "+s"(hi)); return (T*)(((unsigned long long)hi << 32) | lo); }
__device__ __forceinline__ int OPQ(int v) { asm volatile("" : "+s"(v)); return v; }
constexpr int N_PHASES = 19;
#ifndef RUN_PHASES
#define RUN_PHASES N_PHASES
#endif
#ifndef PHMASK
#define PHMASK 0x3ff
#endif
#define EN(k) (((PHMASK) >> (k)) & 1)
#ifdef REPEAT_PH
#define RPT_COEF(ph, c) ((args.seq == 1 && (ph) == REPEAT_PH) ? 0.0f : (c))
#else
#define RPT_COEF(ph, c) (c)
#endif
#ifdef PROBE_TS
#define PROBE_LAST 1
#else
#define PROBE_LAST 0
#endif
#ifndef FAST_ATTN
#define FAST_ATTN 3
#endif
#ifndef MK_ONE_LAUNCH
#define MK_ONE_LAUNCH 0
#endif
__global__ void __launch_bounds__(NWAVES * 64, 2) fwd_kernel(Args args) {
    extern __shared__ __attribute__((aligned(16))) unsigned char lds[];
    Frame F;
    F.lds = (LAS unsigned char*)lds;
    F.MISC = nullptr;
    F.tid = threadIdx.x; F.lane = F.tid & 63; F.wave = __builtin_amdgcn_readfirstlane(F.tid >> 6);
    F.G = gridDim.x; { const int bx = blockIdx.x; F.vcu = (F.G % 8 == 0) ? (bx % 8) * (F.G / 8) + bx / 8 : bx; }
    F.ctl = (gu32*)(opq_ptr(args.ws) + WS_CTL);
    for (int u = F.tid; u < (LDS_BYTES - LDSCTL_OFF) / 4; u += NWAVES * 64) ((LAS unsigned*)(F.lds + LDSCTL_OFF))[u] = 0u;
    __syncthreads();
    if (MK_ONE_LAUNCH) (void)xcd_barrier_post((unsigned*)(opq_ptr(args.ws) + WS_CTL) + CW_BAR + args.seq * 16384, (volatile LAS unsigned*)(F.lds + MISC_OFF) + 8);
    if (!MK_ONE_LAUNCH) launch_wait((gu32*)(opq_ptr(args.ws) + WS_CTL), args.seq, args.prev_blocks);
    const int lo = args.ph_lo, hi = args.ph_hi;
#define IN(k) (lo <= (k) && (k) < hi)
#ifdef PROBE_TS
#define TSTAMP(k) do { if (blockIdx.x == 0 && F.wave == 0) ((unsigned long long*)(ws_reload() + 1792 * 1024))[(k)] = __builtin_amdgcn_s_memrealtime(); } while (0)
#elif defined(PT_PHASE)
#define TSTAMP(k) do { if (F.wave == 0 && ((k) == PT_PHASE || (k) == PT_PHASE + 1)) ((volatile unsigned long long*)(ws_reload() + 1792 * 1024))[blockIdx.x * 4 + ((k) - PT_PHASE)] = __builtin_amdgcn_s_memrealtime(); } while (0)
#else
#define TSTAMP(k) do { } while (0)
#endif
#define SEAM(k) do { if (MK_ONE_LAUNCH && IN(k) && (IN((k) + 1) || PROBE_LAST)) { XcdBarrier b_; b_.bar = (unsigned*)(opq_ptr(args.ws) + WS_CTL) + CW_BAR + args.seq * 16384; b_.x = xb_xcc_id(); b_.st = (volatile LAS unsigned*)(F.lds + MISC_OFF) + 8; xcd_barrier(b_, F.wave); } TSTAMP((k) + 1); } while (0)
#define XB ((bf16*)(opq_ptr(args.ws) + WS_XB))
#define SSQ ((float*)(opq_ptr(args.ws) + WS_SSQ))
#define U ((bf16*)(opq_ptr(args.ws) + WS_U))
#define xout (opq_ptr(args.out))

    TSTAMP(0);
    if (EN(9) && IN(0)) { p0_prologue(F, args); SEAM(0); }
#ifdef IDLE_US
    { const unsigned long long t0_ = __builtin_amdgcn_s_memrealtime();
      while (__builtin_amdgcn_s_memrealtime() - t0_ < (unsigned long long)(IDLE_US) * 100ull) __builtin_amdgcn_s_sleep(64); }
#endif

    for (int l = 0; l < DEPTH; ++l) {
        const int pb = 1 + 9 * l;
        if (EN(0) && IN(pb + 0)) {
            pg8::Gemm g{XB, (const bf16*)(opq_ptr(args.ws) + WS_W13) + (size_t)(l * 2 + 0) * N13 * DM, M, N13, DM, DM}; pg8::StaticOrder S; S.init(M, N13, OPQ(F.G), OPQ((int)blockIdx.x));
            EpiSwiGLU E{U, rinv_fill(F.lds, SSQ, S, 11, F.wave)};
            pg8::gemm_phase<EpiSwiGLU, pg8::StaticOrder, true, true>(F.lds + RING_OFF, g, S, E, F.wave);
            SEAM(pb + 0);
        }
        if (EN(1) && IN(pb + 1)) {
            pg8::Gemm g{U, (const bf16*)(opq_ptr(args.ws) + WS_W2) + (size_t)(l * 2 + 0) * DM * DFF, M, DM, DFF, DFF}; pg8::StaticOrder S; S.init(M, DM, OPQ(F.G), OPQ((int)blockIdx.x));
            EpiResid E{nullptr, XB, SSQ, 0.5f};
            pg8::gemm_phase<EpiResid, pg8::StaticOrder, true, true>(F.lds + RING_OFF, g, S, E, F.wave);
            SEAM(pb + 1);
        }
        if (EN(2) && IN(pb + 2)) {
            pg8::Gemm g{XB, (const bf16*)(opq_ptr(args.ws) + WS_WIN) + (size_t)l * NIN * DM, M, NIN, DM, DM}; pg8::StaticOrder S; S.init(M, NIN, OPQ(F.G), OPQ((int)blockIdx.x));
            EpiWin E{rinv_fill(F.lds, SSQ, S, 10, F.wave), (bf16*)(opq_ptr(args.ws) + WS_QN), (bf16*)(opq_ptr(args.ws) + WS_QM), (bf16*)(opq_ptr(args.ws) + WS_KVH), (bf16*)(opq_ptr(args.ws) + WS_SGN), (bf16*)(opq_ptr(args.ws) + WS_SGM), (float*)(opq_ptr(args.ws) + WS_GN),
                     (float*)(opq_ptr(args.ws) + WS_KMS) + (size_t)l * 16 * 8 * 8 * 64, opq_ptr(args.in[6]) + (size_t)l * 4 * 64, opq_ptr(args.in[7]) + (size_t)l * 2 * 64};
            pg8::gemm_phase<EpiWin, pg8::StaticOrder, true, true>(F.lds + RING_OFF, g, S, E, F.wave);
            SEAM(pb + 2);
        }
        if (EN(3) && IN(pb + 3)) {
#pragma unroll 1
            for (int kv = 0; kv < 2; ++kv) {
                const int cshift = (int)((blockIdx.x + (kv ? F.G / 2 : 0)) % F.G);
                bf16* hid = (bf16*)(opq_ptr(args.ws) + WS_HID) + (size_t)kv * 4096 * 256;
                { pg8::Gemm g{(const bf16*)(opq_ptr(args.ws) + WS_KVH) + (size_t)(2 * kv) * M * 64, (const bf16*)(opq_ptr(args.ws) + WS_WC1) + (size_t)(l * 2 + kv) * 256 * 2048, 4096, 256, 2048, 1024};
                  pg8::StaticOrder S; S.init(4096, 256, OPQ(F.G), OPQ(cshift));
                  EpiCmp1 E{hid, (const float*)(opq_ptr(args.ws) + WS_BC1) + (l * 2 + kv) * 256};
                  pg8::gemm_phase<EpiCmp1, pg8::StaticOrder, true, true>(F.lds + RING_OFF, g, S, E, F.wave); }
                VM_WAIT(); __syncthreads();
                { pg8::Gemm g{hid, (const bf16*)(opq_ptr(args.ws) + WS_WC2) + (size_t)(l * 2 + kv) * 256 * 256, 4096, 256, 256, 256};
                  pg8::StaticOrder S; S.init(4096, 256, OPQ(F.G), OPQ(cshift));
                  EpiCmp2 E{(bf16*)(opq_ptr(args.ws) + WS_CMP) + (size_t)kv * 4096 * 64, kv == 0 ? opq_ptr(args.in[6]) + (size_t)l * 4 * 64 + 64 : nullptr};
                  pg8::gemm_phase<EpiCmp2, pg8::StaticOrder, true, true>(F.lds + RING_OFF, g, S, E, F.wave); }
            }
#if FAST_ATTN & 1
            __syncthreads();
            { int tid_a; asm volatile("v_mbcnt_lo_u32_b32 %0, -1, 0\n\tv_mbcnt_hi_u32_b32 %0, -1, %0" : "=v"(tid_a)); tid_a += F.wave * 64;
              att::moba_phase(F.lds + RING_OFF, tid_a, F.wave, OPQ(F.vcu), OPQ(F.G), opq_ptr(args.ws), l, (bf16*)opq_ptr(args.out), 2 * l);
#ifdef DUP_MOBA
#define DUPM_(q) if (l == 0) { SEAM(pb + 3); att::moba_phase(F.lds + RING_OFF, tid_a, F.wave, OPQ(F.vcu), OPQ(F.G), opq_ptr(args.ws), l, (bf16*)opq_ptr(args.out), q); }
              DUPM_(8)
#if DUP_MOBA >= 2
              DUPM_(10)
#endif
#if DUP_MOBA >= 3
              DUPM_(11)
#endif
#if DUP_MOBA >= 4
              DUPM_(12)
#endif
#endif
            }
#endif
            SEAM(pb + 3);
        }
        if (EN(4) && IN(pb + 4)) {
#if FAST_ATTN & 2
            { int tid_a; asm volatile("v_mbcnt_lo_u32_b32 %0, -1, 0\n\tv_mbcnt_hi_u32_b32 %0, -1, %0" : "=v"(tid_a)); tid_a += F.wave * 64;
              att::nsa_phase(F.lds + RING_OFF, tid_a, F.wave, OPQ(F.vcu), OPQ(F.G), opq_ptr(args.ws), l, (bf16*)opq_ptr(args.out), 2 * l + 1);
#ifdef DUP_NSA
#define DUPN_(q) if (l == 0) { SEAM(pb + 4); att::nsa_phase(F.lds + RING_OFF, tid_a, F.wave, OPQ(F.vcu), OPQ(F.G), opq_ptr(args.ws), l, (bf16*)opq_ptr(args.out), q); }
              DUPN_(9)
#if DUP_NSA >= 2
              DUPN_(13)
#endif
#if DUP_NSA >= 3
              DUPN_(14)
#endif
#if DUP_NSA >= 4
              DUPN_(15)
#endif
#endif
            }
#endif
            SEAM(pb + 4); }
        if (EN(5) && IN(pb + 5)) {
            { pg8::Gemm g{(const bf16*)xout  , (const bf16*)(opq_ptr(args.ws) + WS_WUP) + (size_t)l * 2 * DM * 512, M, DM, DM, DM};
              pg8::StaticOrder S; S.init(M, DM, OPQ(F.G), OPQ((int)blockIdx.x));
              EpiUp2 E{(bf16*)(opq_ptr(args.ws) + WS_Y), (const unsigned char*)(opq_ptr(args.ws) + WS_SGN), (const unsigned char*)(opq_ptr(args.ws) + WS_SGM)};
              pg8::gemm_phase<EpiUp2, pg8::StaticOrder, true, true>(F.lds + RING_OFF, g, S, E, F.wave); }
            SEAM(pb + 5);
        }
        if (EN(6) && IN(pb + 6)) {
            pg8::Gemm g{(const bf16*)(opq_ptr(args.ws) + WS_Y), (const bf16*)(opq_ptr(args.ws) + WS_WOUT) + (size_t)l * DM * DM, M, DM, DM, DM}; pg8::StaticOrder S; S.init(M, DM, OPQ(F.G), OPQ((int)blockIdx.x));
            EpiResid E{nullptr, XB, SSQ, 1.0f};
            pg8::gemm_phase<EpiResid, pg8::StaticOrder, true, true>(F.lds + RING_OFF, g, S, E, F.wave);
            SEAM(pb + 6);
        }
        if (EN(7) && IN(pb + 7)) {
            pg8::Gemm g{XB, (const bf16*)(opq_ptr(args.ws) + WS_W13) + (size_t)(l * 2 + 1) * N13 * DM, M, N13, DM, DM}; pg8::StaticOrder S; S.init(M, N13, OPQ(F.G), OPQ((int)blockIdx.x));
            EpiSwiGLU E{U, rinv_fill(F.lds, SSQ, S, 11, F.wave)};
            pg8::gemm_phase<EpiSwiGLU, pg8::StaticOrder, true, true>(F.lds + RING_OFF, g, S, E, F.wave);
            SEAM(pb + 7);
        }
        if (EN(8) && IN(pb + 8)) {
            pg8::Gemm g{U, (const bf16*)(opq_ptr(args.ws) + WS_W2) + (size_t)(l * 2 + 1) * DM * DFF, M, DM, DFF, DFF}; pg8::StaticOrder S; S.init(M, DM, OPQ(F.G), OPQ((int)blockIdx.x));
            EpiResid E{l == DEPTH - 1 ? xout : nullptr, XB, SSQ, 0.5f};
            pg8::gemm_phase<EpiResid, pg8::StaticOrder, true, true>(F.lds + RING_OFF, g, S, E, F.wave);
            SEAM(pb + 8);
        }
    }
#ifdef PROBE_TS
    { const unsigned long long* ts = (const unsigned long long*)(ws_reload() + 1792 * 1024);
      if (blockIdx.x == 0) { const float dA = (float)(ts[PROBE_A + 1] - ts[PROBE_A]) * 0.01f, dB = (PROBE_B < 0) ? 100.0f : (float)(ts[(PROBE_B < 0 ? 0 : PROBE_B) + 1] - ts[(PROBE_B < 0 ? 0 : PROBE_B)]) * 0.01f;
          float* o = opq_ptr(args.out);
          int lp_; asm volatile("v_mbcnt_lo_u32_b32 %0, -1, 0\n\tv_mbcnt_hi_u32_b32 %0, -1, %0" : "=v"(lp_)); lp_ += F.wave * 64;
          if (lp_ == 0) o[0] = 100.0f * dA;
          for (int i = lp_; i < (1 << 20); i += 512) o[(1 << 20) + i] = dB; } }
#endif
#ifdef PT_PHASE
    if (F.wave == 0) { volatile unsigned long long* ts = (volatile unsigned long long*)(ws_reload() + 1792 * 1024) + blockIdx.x * 4;
        const unsigned long long d_ = ts[1] - ts[0], te_ = __builtin_amdgcn_s_memrealtime() + (unsigned long long)(PT_AMP) * d_;
        while (__builtin_amdgcn_s_memrealtime() < te_) __builtin_amdgcn_s_sleep(64); }
#endif
    if (!MK_ONE_LAUNCH) launch_done((gu32*)(opq_ptr(args.ws) + WS_CTL), args.seq);
#undef IN
#undef SEAM
#undef XB
#undef SSQ
#undef U
#undef xout
}

extern "C" void kernel_launch(void* const* d_in, const int* in_sizes, int n_in, void* d_out, int out_size, void* d_ws, size_t ws_size, hipStream_t stream) {
    static int grid = 0;
    if (grid == 0) {
        if (n_in != 14 || in_sizes[0] != M * DM || out_size != M * DM || ws_size < WS_END) { fprintf(stderr, "kernel_launch: unexpected shapes (n_in %d, in0 %d, out %d, ws %zu); nothing launched\n", n_in, n_in > 0 ? in_sizes[0] : -1, out_size, ws_size); grid = -1; return; }
        int dev = 0, cus = 0, per_cu = 0;
        if (hipGetDevice(&dev) != hipSuccess || hipDeviceGetAttribute(&cus, hipDeviceAttributeMultiprocessorCount, dev) != hipSuccess) { grid = -1; return; }
        if (hipFuncSetAttribute((const void*)fwd_kernel, hipFuncAttributeMaxDynamicSharedMemorySize, LDS_BYTES) != hipSuccess) { fprintf(stderr, "kernel_launch: hipFuncSetAttribute failed\n"); grid = -1; return; }
        if (hipOccupancyMaxActiveBlocksPerMultiprocessor(&per_cu, (const void*)fwd_kernel, NWAVES * 64, LDS_BYTES) != hipSuccess || per_cu < 1)
            fprintf(stderr, "kernel_launch: note: occupancy query reports %d workgroups per CU\n", per_cu);
        (void)hipGetLastError();
        grid = cus;
    }
    if (grid < 0) return;
    if (hipMemsetAsync((char*)d_ws + WS_CTL, 0, CTL_ZERO_BYTES, stream) != hipSuccess) return;
    Args a{};
    for (int i = 0; i < 14; ++i) a.in[i] = (const float*)d_in[i];
    a.out = (float*)d_out; a.ws = (unsigned char*)d_ws;
#if MK_ONE_LAUNCH
#ifdef REPEAT_PH
    a.ph_lo = 0; a.ph_hi = REPEAT_PH + 1; a.seq = 0;
    hipLaunchKernelGGL(fwd_kernel, dim3(grid), dim3(NWAVES * 64), LDS_BYTES, stream, a);
    a.ph_lo = REPEAT_PH; a.ph_hi = N_PHASES; a.seq = 1;
    hipLaunchKernelGGL(fwd_kernel, dim3(grid), dim3(NWAVES * 64), LDS_BYTES, stream, a);
#else
    a.ph_lo = 0; a.ph_hi = N_PHASES;
    hipLaunchKernelGGL(fwd_kernel, dim3(grid), dim3(NWAVES * 64), LDS_BYTES, stream, a);
#endif
#else
    int seq = 0, prev = 0;
    for (int p = 0; p < RUN_PHASES; ++p) {
        a.ph_lo = p; a.ph_hi = p + 1;
        const int k = (p - 1) % 9, l = (p - 1) / 9;
        if (p >= 1 && k == 4 && !(FAST_ATTN & 2)) { a.seq = seq++; a.prev_blocks = prev; prev = 4 * grid; hipLaunchKernelGGL(slow_nsa_kernel, dim3(4 * grid), dim3(256), 0, stream, a, l); continue; }
        a.seq = seq++; a.prev_blocks = prev; prev = grid;
        hipLaunchKernelGGL(fwd_kernel, dim3(grid), dim3(NWAVES * 64), LDS_BYTES, stream, a);
        if (p >= 1 && k == 3 && !(FAST_ATTN & 1)) { a.seq = seq++; a.prev_blocks = prev; prev = 4 * grid; hipLaunchKernelGGL(slow_moba_kernel, dim3(4 * grid), dim3(256), 0, stream, a, l); }
    }
#endif
}
```

```cpp
#define MK_ONE_LAUNCH 1
#include <hip/hip_runtime.h>
#include <cstdio>
#include <cstdint>
namespace pg8 {
#define PG8_LAS __attribute__((address_space(3)))
typedef unsigned short bf16_t;
typedef short bf16x8 __attribute__((ext_vector_type(8)));
typedef float f32x4 __attribute__((ext_vector_type(4)));
typedef unsigned u32x4 __attribute__((ext_vector_type(4)));
constexpr int BM = 256, BK = 64, HALF = 128, HTB = HALF * BK * 2  , STAGE_BYTES = 8 * HTB, NXCD = 8, WGM = 8;

__host__ __device__ __forceinline__ int lds_byte(int r, int c) { const int st = (r >> 4) * 2 + (c >> 5), rr = r & 15, cc = c & 31, ob = rr * 64 + cc * 2; return st * 1024 + (ob ^ (((ob >> 9) & 1) << 5)); }
__host__ __device__ __forceinline__ void stage_rc(int b, int& R, int& C) { const int st = b / 1024, sb = b % 1024, swz = sb ^ (((sb >> 9) & 1) << 5); R = (st >> 1) * 16 + swz / 64; C = (st & 1) * 32 + (swz % 64) / 2; }
__host__ __device__ __forceinline__ int perm32(int rho) { const int n = rho >> 4, i = rho & 15; return 8 * (i >> 2) + 4 * n + (i & 3); }

struct Unit { int pm, pn; };
template <class T, class = void> struct HasMid { static constexpr bool value = false; };
template <class T> struct HasMid<T, decltype((void)T::MID_HOOK)> { static constexpr bool value = T::MID_HOOK; };
struct Gemm { const bf16_t* A; const bf16_t* Bt; int M, N, K, lda; };

struct StaticOrder {
    int nM, nN, nwg, G, c;
    __host__ __device__ void init(int M, int N, int G_, int c_) { nM = M / BM; nN = N / BM; nwg = nM * nN; G = G_; c = c_; }
    __host__ __device__ bool next(int i, Unit& u) const {
        const long L = (long)i * G + c; if (L >= nwg) return false;
        int wgid = (int)L; { const int q = nwg / NXCD, r = nwg % NXCD, xcd = wgid % NXCD, off = wgid / NXCD; wgid = (xcd < r ? xcd * (q + 1) : r * (q + 1) + (xcd - r) * q) + off; }
        const int nig = WGM * nN, gid = wgid / nig, fm = gid * WGM, gsz = (nM - fm) < WGM ? (nM - fm) : WGM;
        u.pm = fm + ((wgid % nig) % gsz); u.pn = (wgid % nig) / gsz; return true;
    }
    __device__ __forceinline__ void a_ready(const Unit&) const {}
    __device__ __forceinline__ void done(const Unit&) const {}
};

typedef float f32x2_cv __attribute__((ext_vector_type(2))); typedef __bf16 bf16x2_cv __attribute__((ext_vector_type(2)));
__device__ __forceinline__ unsigned cvt_pk_bf16(float lo, float hi) { f32x2_cv v = {lo, hi}; bf16x2_cv b = __builtin_convertvector(v, bf16x2_cv); return __builtin_bit_cast(unsigned, b); }
typedef float f32x2 __attribute__((ext_vector_type(2)));
template <class Epi, class Sched, bool ALIGN_EPI = false, bool SP2 = false, int AUX_A = 0>
__device__ __forceinline__ void gemm_phase(PG8_LAS unsigned char* lds, const Gemm g, const Sched& S, const Epi& E, const int wave_id  ) {
    int tid_; asm volatile("v_mbcnt_lo_u32_b32 %0, -1, 0\n\tv_mbcnt_hi_u32_b32 %0, -1, %0" : "=v"(tid_)); tid_ += wave_id * 64;
    const int tid = tid_, wid = __builtin_amdgcn_readfirstlane(tid >> 6), lane = tid & 63, wr = wid >> 2, wc = wid & 3, fr = lane & 15, fq = lane >> 4;
    const int K = g.K, nt = K / BK;
    unsigned voffA[2], voffB[2];
#pragma unroll
    for (int i = 0; i < 2; ++i) { int R, C; stage_rc(tid * 16 + i * 8192, R, C); const int Rb = Epi::PERM ? ((R & ~31) + perm32(R & 31)) : R;
        voffA[i] = (unsigned)(R * g.lda + C) * 2u; voffB[i] = (unsigned)(Rb * K + C) * 2u; }
    const size_t kstep = (size_t)(BK * 2);
    const size_t hstep = (size_t)HALF * K * 2;
    const size_t tstep = 2 * hstep; const size_t hstepA = (size_t)HALF * g.lda * 2, tstepA = 2 * hstepA;
    const unsigned ldsw = (unsigned)wid * 1024u;
    const int aoff = lds_byte(wr * 64 + fr, fq * 8), boff = lds_byte(wc * 32 + fr, fq * 8);
#define PG8_SA(b, h) (((b) * 2 + (h)) * HTB)
#define PG8_SB(b, h) ((4 + (b) * 2 + (h)) * HTB)
#define PG8_STAGEA(bufoff, gbase, voff) do { _Pragma("unroll") for (int _i = 0; _i < 2; ++_i) \
        __builtin_amdgcn_global_load_lds((const unsigned*)((const char*)(gbase) + (voff)[_i]), (PG8_LAS unsigned*)(lds + (bufoff) + ldsw + _i * 8192), 16, 0, AUX_A); } while (0)
#define PG8_STAGE(bufoff, gbase, voff) do { _Pragma("unroll") for (int _i = 0; _i < 2; ++_i) \
        __builtin_amdgcn_global_load_lds((const unsigned*)((const char*)(gbase) + (voff)[_i]), (PG8_LAS unsigned*)(lds + (bufoff) + ldsw + _i * 8192), 16, 0, 0); } while (0)
#define PG8_LDA(dst, b, h) do { _Pragma("unroll") for (int m = 0; m < 4; ++m) _Pragma("unroll") for (int k = 0; k < 2; ++k) dst[m][k] = *(const PG8_LAS bf16x8*)(lds + PG8_SA(b, h) + aoff + m * 2048 + k * 1024); } while (0)
#define PG8_LDB(dst, b, h) do { _Pragma("unroll") for (int n = 0; n < 2; ++n) _Pragma("unroll") for (int k = 0; k < 2; ++k) dst[n][k] = *(const PG8_LAS bf16x8*)(lds + PG8_SB(b, h) + boff + n * 2048 + k * 1024); } while (0)
#define PG8_MMA(ai, bj, At, Bt) do { __builtin_amdgcn_s_setprio(1); _Pragma("unroll") for (int m = 0; m < 4; ++m) _Pragma("unroll") for (int n = 0; n < 2; ++n) _Pragma("unroll") for (int k = 0; k < 2; ++k) \
        acc[ai][bj][m][n] = __builtin_amdgcn_mfma_f32_16x16x32_bf16(Bt[n][k], At[m][k], acc[ai][bj][m][n], 0, 0, 0); __builtin_amdgcn_s_setprio(0); } while (0)
#define PG8_WAIT_V(n) asm volatile("s_waitcnt vmcnt(" #n ")" ::: "memory")
#define PG8_WAIT_L(n) asm volatile("s_waitcnt lgkmcnt(" #n ")" ::: "memory")
#define PG8_BAR __builtin_amdgcn_s_barrier()
#define PG8_SCHED __builtin_amdgcn_sched_barrier(0)
    Unit cur, nxt; int ui = 0;
    if (!S.next(0, cur)) return;
    f32x4 acc[2][2][4][2];
#pragma unroll
    for (int a = 0; a < 2; ++a)
#pragma unroll
        for (int b = 0; b < 2; ++b)
#pragma unroll
            for (int m = 0; m < 4; ++m)
#pragma unroll
                for (int n = 0; n < 2; ++n) acc[a][b][m][n] = (f32x4){0.f, 0.f, 0.f, 0.f};
    bf16x8 At[4][2], B0[2][2], B1[2][2];
    const char* cA = (const char*)g.A + (size_t)cur.pm * tstepA; const char* cB = (const char*)g.Bt + (size_t)cur.pn * tstep;
    S.a_ready(cur);
    if constexpr (SP2) {
        PG8_STAGE(PG8_SB(0, 0), cB, voffB); PG8_STAGE(PG8_SB(0, 1), cB + hstep, voffB); PG8_STAGEA(PG8_SA(0, 0), cA, voffA); PG8_STAGEA(PG8_SA(0, 1), cA + hstepA, voffA);
        if (wr == 1) PG8_BAR;
        PG8_WAIT_V(2); PG8_BAR;
        PG8_STAGE(PG8_SB(1, 0), cB + kstep, voffB); PG8_STAGEA(PG8_SA(1, 0), cA + kstep, voffA); PG8_STAGE(PG8_SB(1, 1), cB + hstep + kstep, voffB);
        PG8_WAIT_V(6); PG8_BAR;
    } else {
        PG8_STAGE(PG8_SB(0, 0), cB, voffB); PG8_STAGEA(PG8_SA(0, 0), cA, voffA); PG8_STAGE(PG8_SB(0, 1), cB + hstep, voffB); PG8_STAGEA(PG8_SA(0, 1), cA + hstepA, voffA);
        if (wr == 1) PG8_BAR;
        PG8_WAIT_V(4); PG8_BAR;
        PG8_STAGE(PG8_SB(1, 0), cB + kstep, voffB); PG8_STAGEA(PG8_SA(1, 0), cA + kstep, voffA); PG8_STAGE(PG8_SB(1, 1), cB + hstep + kstep, voffB);
        PG8_WAIT_V(6); PG8_BAR;
    }
    for (;;) {
        const bool has_next = S.next(ui + 1, nxt);
        const char* nA = has_next ? (const char*)g.A + (size_t)nxt.pm * tstepA : cA; const char* nB = has_next ? (const char*)g.Bt + (size_t)nxt.pn * tstep : cB;
        for (int t = 0; t < nt; t += 2) {
            if constexpr (HasMid<Epi>::value) { if (t == nt / 2) { int lm_; asm volatile("v_mbcnt_lo_u32_b32 %0, -1, 0\n\tv_mbcnt_hi_u32_b32 %0, -1, %0" : "=v"(lm_)); E.mid(acc, cur, wr, wc, lm_ & 15, lm_ >> 4); } }
            const bool last = (t == nt - 2);
            const char* a1 = cA + (size_t)(t + 1) * kstep;
            const char* a2 = last ? nA : cA + (size_t)(t + 2) * kstep; const char* b2 = last ? nB : cB + (size_t)(t + 2) * kstep;
            const char* a3 = a2 + kstep; const char* b3 = b2 + kstep;
            if (last && has_next) S.a_ready(nxt);
            if constexpr (SP2) {
            PG8_LDB(B0, 0, 0); PG8_LDB(B1, 0, 1); PG8_SCHED; PG8_LDA(At, 0, 0); PG8_STAGEA(PG8_SA(1, 1), a1 + hstepA, voffA);
            PG8_WAIT_V(8); PG8_WAIT_L(0); PG8_BAR; PG8_MMA(0, 0, At, B0); PG8_MMA(0, 1, At, B1); PG8_BAR; PG8_SCHED;
            PG8_LDA(At, 0, 1); PG8_STAGE(PG8_SB(0, 0), b2, voffB); PG8_STAGE(PG8_SB(0, 1), b2 + hstep, voffB); PG8_STAGEA(PG8_SA(0, 0), a2, voffA);
            PG8_WAIT_V(8); PG8_WAIT_L(0); PG8_BAR; PG8_MMA(1, 0, At, B0); PG8_MMA(1, 1, At, B1); PG8_BAR; PG8_SCHED;
            PG8_LDB(B0, 1, 0); PG8_LDB(B1, 1, 1); PG8_SCHED; PG8_LDA(At, 1, 0); PG8_STAGEA(PG8_SA(0, 1), a2 + hstepA, voffA);
            PG8_WAIT_V(8); PG8_WAIT_L(0); PG8_BAR; PG8_MMA(0, 0, At, B0); PG8_MMA(0, 1, At, B1); PG8_BAR; PG8_SCHED;
            PG8_LDA(At, 1, 1); PG8_STAGE(PG8_SB(1, 0), b3, voffB); PG8_STAGE(PG8_SB(1, 1), b3 + hstep, voffB); PG8_STAGEA(PG8_SA(1, 0), a3, voffA);
            PG8_WAIT_V(8); PG8_WAIT_L(0); PG8_BAR; PG8_MMA(1, 0, At, B0); PG8_MMA(1, 1, At, B1); PG8_BAR; PG8_SCHED;
            } else {
            PG8_LDB(B0, 0, 0); PG8_SCHED; PG8_LDA(At, 0, 0); PG8_STAGEA(PG8_SA(1, 1), a1 + hstepA, voffA);
            PG8_WAIT_L(8); PG8_BAR; PG8_WAIT_L(0); PG8_MMA(0, 0, At, B0); PG8_BAR; PG8_SCHED;
            PG8_LDB(B1, 0, 1); PG8_STAGE(PG8_SB(0, 0), b2, voffB);
            PG8_BAR; PG8_WAIT_L(0); PG8_MMA(0, 1, At, B1); PG8_BAR;
            PG8_LDA(At, 0, 1); PG8_STAGEA(PG8_SA(0, 0), a2, voffA);
            PG8_BAR; PG8_WAIT_L(0); PG8_MMA(1, 0, At, B0); PG8_BAR; PG8_SCHED;
            PG8_STAGE(PG8_SB(0, 1), b2 + hstep, voffB);
            PG8_WAIT_V(6); PG8_BAR; PG8_MMA(1, 1, At, B1); PG8_BAR;
            PG8_LDB(B0, 1, 0); PG8_SCHED; PG8_LDA(At, 1, 0); PG8_STAGEA(PG8_SA(0, 1), a2 + hstepA, voffA);
            PG8_WAIT_L(8); PG8_BAR; PG8_WAIT_L(0); PG8_MMA(0, 0, At, B0); PG8_BAR; PG8_SCHED;
            PG8_LDB(B1, 1, 1); PG8_STAGE(PG8_SB(1, 0), b3, voffB);
            PG8_BAR; PG8_WAIT_L(0); PG8_MMA(0, 1, At, B1); PG8_BAR;
            PG8_LDA(At, 1, 1); PG8_STAGEA(PG8_SA(1, 0), a3, voffA);
            PG8_BAR; PG8_WAIT_L(0); PG8_MMA(1, 0, At, B0); PG8_BAR; PG8_SCHED;
            PG8_STAGE(PG8_SB(1, 1), b3 + hstep, voffB);
            PG8_WAIT_V(6); PG8_BAR; PG8_MMA(1, 1, At, B1); PG8_BAR;
            }
        }
        if constexpr (ALIGN_EPI) { if (wr == 0) PG8_BAR; }
        if constexpr (!Epi::AFTER_DRAIN) { int le_; asm volatile("v_mbcnt_lo_u32_b32 %0, -1, 0\n\tv_mbcnt_hi_u32_b32 %0, -1, %0" : "=v"(le_));   E(acc, cur, wr, wc, le_ & 15, le_ >> 4); S.done(cur); }
        if (!has_next) break;
#pragma unroll
        for (int a = 0; a < 2; ++a)
#pragma unroll
            for (int b = 0; b < 2; ++b)
#pragma unroll
                for (int m = 0; m < 4; ++m)
#pragma unroll
                    for (int n = 0; n < 2; ++n) acc[a][b][m][n] = (f32x4){0.f, 0.f, 0.f, 0.f};
        cur = nxt; cA = nA; cB = nB; ++ui;
        if constexpr (ALIGN_EPI) { if (wr == 1) PG8_BAR; }
    }
    PG8_WAIT_V(0);
    if constexpr (!ALIGN_EPI) { if (wr == 0) PG8_BAR; }
    PG8_BAR;
    if constexpr (Epi::AFTER_DRAIN) { E.fused(acc, cur, wr, wc, fr, fq, lds, wid, lane); S.done(cur); }
#undef PG8_SA
#undef PG8_SB
#undef PG8_STAGE
#undef PG8_STAGEA
#undef PG8_LDA
#undef PG8_LDB
#undef PG8_MMA
#undef PG8_WAIT_V
#undef PG8_WAIT_L
#undef PG8_BAR
#undef PG8_SCHED
}
}
#define GAS __attribute__((address_space(1)))
#define LAS __attribute__((address_space(3)))
typedef unsigned short bf16;
typedef unsigned v4u __attribute__((ext_vector_type(4)));
typedef float f32x4 __attribute__((ext_vector_type(4)));
typedef short bf16x8 __attribute__((ext_vector_type(8)));
typedef GAS unsigned gu32;
typedef GAS unsigned long long gu64;
#define RLX_AGENT __ATOMIC_RELAXED, __HIP_MEMORY_SCOPE_AGENT
#define LDS_WAIT() asm volatile("s_waitcnt lgkmcnt(0)" ::: "memory")
#define VM_WAIT() asm volatile("s_waitcnt vmcnt(0)" ::: "memory")
__device__ __forceinline__ unsigned long long rt() { return __builtin_amdgcn_s_memrealtime(); }
__device__ __forceinline__ unsigned f2bf(float f) { unsigned u = __builtin_bit_cast(unsigned, f); return (u + 0x7fffu + ((u >> 16) & 1u)) >> 16; }
__device__ __forceinline__ unsigned pk2(float lo, float hi) { return f2bf(lo) | (f2bf(hi) << 16); }
#define XB_TMO      128
#define XB_XCNT(j)  (256  + 64 * (j))
#define XB_XSUB(j)  (1280 + 64 * (j))
#define XB_XGEN(j)  (2304 + 64 * (j))
#define XB_TOP      3328
#define XB_TOPGEN   3392
#define XCD_BAR_WORDS 3456
#define XB_SPIN_CAP (1u << 18)

__device__ __forceinline__ unsigned xb_ld(unsigned* p)              { return __hip_atomic_load((GAS unsigned*)p, __ATOMIC_RELAXED, __HIP_MEMORY_SCOPE_AGENT); }
__device__ __forceinline__ unsigned xb_add(unsigned* p, unsigned v) { return __hip_atomic_fetch_add((GAS unsigned*)p, v, __ATOMIC_RELAXED, __HIP_MEMORY_SCOPE_AGENT); }
__device__ __forceinline__ unsigned xb_xcc_id() { return (unsigned)__builtin_amdgcn_s_getreg((3 << 11) | 20) & 0xFu; }
#define XB_SPIN(cond, bar) do { unsigned _sp = 0; while (cond) { __builtin_amdgcn_s_sleep(1); \
    if ((++_sp & 255u) == 0u) { if (xb_ld(&(bar)[XB_TMO])) break; if (_sp > XB_SPIN_CAP) { xb_add(&(bar)[XB_TMO], 1u); break; } } } } while (0)

struct XcdBarrier {
    unsigned* bar; unsigned x;
    volatile LAS unsigned* st;
};

__device__ __forceinline__ XcdBarrier xcd_barrier_post(unsigned* bar, volatile LAS unsigned* st) {
    XcdBarrier b; b.bar = bar; b.x = xb_xcc_id(); b.st = st;
    if (threadIdx.x == 0) (void)xb_add(&bar[XB_XCNT(b.x)], 1u);
    return b;
}
__device__ __forceinline__ void xcd_barrier_complete(unsigned* bar, unsigned x, unsigned& nloc, unsigned& nx) {
    const unsigned G = gridDim.x * gridDim.y * gridDim.z;
    unsigned sum, cnt, mine, sp = 0u;
    for (;;) {
        sum = 0u; cnt = 0u; mine = 0u;
#pragma unroll
        for (unsigned j = 0; j < 16; ++j) { const unsigned c = xb_ld(&bar[XB_XCNT(j)]); sum += c; cnt += (c > 0u) ? 1u : 0u; mine = (j == x) ? c : mine; }
        if (sum == G) break;
        __builtin_amdgcn_s_sleep(1);
        if ((++sp & 255u) == 0u) { if (xb_ld(&bar[XB_TMO])) break; if (sp > XB_SPIN_CAP) { xb_add(&bar[XB_TMO], 1u); break; } }
    }
    nloc = mine > 0u ? mine : 1u; nx = cnt > 0u ? cnt : 1u;
}

__device__ __forceinline__ void xcd_barrier(const XcdBarrier& b, const int wave_id) {
    asm volatile("s_waitcnt vmcnt(0)" ::: "memory");
    __syncthreads();
    int lane_; asm volatile("v_mbcnt_lo_u32_b32 %0, -1, 0\n\tv_mbcnt_hi_u32_b32 %0, -1, %0" : "=v"(lane_));
    if (wave_id == 0 && lane_ == 0) {
        unsigned* bar = b.bar;
        __builtin_amdgcn_s_waitcnt(0);
        unsigned nloc = b.st[0], nx = b.st[1];
        if (nloc == 0u) { xcd_barrier_complete(bar, b.x, nloc, nx); b.st[0] = nloc; b.st[1] = nx; }
        const unsigned old = xb_add(&bar[XB_XSUB(b.x)], 1u);
        const unsigned gen = old / nloc;
        if (old + 1u == (gen + 1u) * nloc) {
            __builtin_amdgcn_fence(__ATOMIC_RELEASE, "agent");
            asm volatile("s_waitcnt vmcnt(0)" ::: "memory");
            const unsigned og = xb_add(&bar[XB_TOP], 1u);
            const unsigned tg = og / nx;
            if (og + 1u == (tg + 1u) * nx) xb_add(&bar[XB_TOPGEN], 1u);
            else XB_SPIN(xb_ld(&bar[XB_TOPGEN]) == tg, bar);
            __builtin_amdgcn_fence(__ATOMIC_ACQUIRE, "agent");
            xb_add(&bar[XB_XGEN(b.x)], 1u);
            asm volatile("s_waitcnt vmcnt(0)" ::: "memory");
        } else {
            XB_SPIN(xb_ld(&bar[XB_XGEN(b.x)]) == gen, bar);
            __builtin_amdgcn_fence(__ATOMIC_ACQUIRE, "agent");
            asm volatile("s_waitcnt vmcnt(0)" ::: "memory");
        }
    }
    __syncthreads();
}
constexpr int NWAVES = 8;
constexpr int DM = 1024, BATCH = 16, SEQ = 2048, DEPTH = 2, M = BATCH * SEQ, DFF = 2816, INC = 4888;
constexpr int N13 = 2 * DFF, NIN = 5120, NUP = 2048;
constexpr float LOG2E = 1.4426950408889634f;
constexpr float C2 = 0.125f * LOG2E;
constexpr size_t MiB = 1u << 20;
constexpr size_t WS_CTL = 0, CTL_ZERO_BYTES = 2 * MiB;
constexpr size_t WS_KMS = 1 * MiB;
constexpr size_t WS_W13 = 2 * MiB;
constexpr size_t WS_W2 = 46 * MiB;
constexpr size_t WS_WIN = 68 * MiB;
constexpr size_t WS_WUP = 88 * MiB;
constexpr size_t WS_WOUT = 96 * MiB;
constexpr size_t WS_WC1 = 100 * MiB;
constexpr size_t WS_WC2 = 104 * MiB;
constexpr size_t WS_BC1 = 104 * MiB + 512 * 1024;
constexpr size_t WS_SSQ = 105 * MiB;
constexpr size_t WS_GN = 107 * MiB;
constexpr size_t WS_HID = 110 * MiB;
constexpr size_t WS_CMP = 114 * MiB;
constexpr size_t WS_XB = 116 * MiB;
constexpr size_t WS_U = 180 * MiB;
constexpr size_t WS_QN = 180 * MiB, WS_QM = 212 * MiB, WS_KVH = 244 * MiB;
constexpr size_t WS_Y = 180 * MiB;
constexpr size_t WS_SGN = 356 * MiB, WS_SGM = 420 * MiB;
constexpr size_t WS_END = 484 * MiB;
constexpr int CW_TMO = 0, CW_CODE = 1, CW_BAR = 4096, CW_QUEUE = 40960;
constexpr int RING_OFF = 0, RING_BYTES = 131072;
constexpr int LDSCTL_OFF = RING_BYTES, MISC_OFF = LDSCTL_OFF + 320;
constexpr int LDS_BYTES = 147456;
constexpr int RINV_OFF = LDSCTL_OFF + 1024;

using pg8::Unit; using pg8::BM; using pg8::HALF;
typedef unsigned u32x4 __attribute__((ext_vector_type(4)));

__device__ __forceinline__ float bf_lo(unsigned u) { return __uint_as_float(u << 16); }
__device__ __forceinline__ float bf_hi(unsigned u) { return __uint_as_float(u & 0xffff0000u); }
__device__ __forceinline__ float fsigmoid(float v) { return __builtin_amdgcn_rcpf(1.0f + __builtin_amdgcn_exp2f(-LOG2E * v)); }
__device__ __forceinline__ u32x4 pack8(f32x4 a, f32x4 b) { u32x4 w; w.x = pg8::cvt_pk_bf16(a[0], a[1]); w.y = pg8::cvt_pk_bf16(a[2], a[3]); w.z = pg8::cvt_pk_bf16(b[0], b[1]); w.w = pg8::cvt_pk_bf16(b[2], b[3]); return w; }
__device__ __forceinline__ float rinv_row(const float* ssq, int row) {
    const GAS f32x4* p = (const GAS f32x4*)(ssq + (size_t)row * 16);
    const f32x4 a = p[0], b = p[1], c = p[2], d = p[3];
    const float s = (((a[0] + a[1]) + (a[2] + a[3])) + ((b[0] + b[1]) + (b[2] + b[3]))) + (((c[0] + c[1]) + (c[2] + c[3])) + ((d[0] + d[1]) + (d[2] + d[3])));
    return 1.0f / sqrtf(s * (1.0f / 1024.0f) + 1e-6f);
}
__device__ __forceinline__ float dot4(f32x4 a) { return (a[0] * a[0] + a[1] * a[1]) + (a[2] * a[2] + a[3] * a[3]); }

template <int MASK> __device__ __forceinline__ float swz_xor(float v) { return __builtin_bit_cast(float, __builtin_amdgcn_ds_swizzle(__builtin_bit_cast(int, v), (MASK << 10) | 0x1f)); }
__device__ __forceinline__ float add_xor32(float v) { const unsigned u = __builtin_bit_cast(unsigned, v); auto rr = __builtin_amdgcn_permlane32_swap(u, u, false, false); return __builtin_bit_cast(float, (unsigned)rr[0]) + __builtin_bit_cast(float, (unsigned)rr[1]); }
__device__ __forceinline__ float get_xor32(float v, int hi) { const unsigned u = __builtin_bit_cast(unsigned, v); auto rr = __builtin_amdgcn_permlane32_swap(u, u, false, false); return __builtin_bit_cast(float, (unsigned)(hi ? rr[0] : rr[1])); }

struct RinvTab { int pmA, pmB; LAS const float* tab; const float* ssq; };
__device__ __forceinline__ RinvTab rinv_fill(LAS unsigned char* lds_base, const float* ssq, const pg8::StaticOrder& S, int n_units_max, int wave_id) {
    int t_; asm volatile("v_mbcnt_lo_u32_b32 %0, -1, 0\n\tv_mbcnt_hi_u32_b32 %0, -1, %0" : "=v"(t_)); t_ += wave_id * 64;
    pg8::Unit u0, u1; u0.pm = 0; u0.pn = 0; u1 = u0;
    S.next(0, u0); int last = 0;
    for (int i = 1; i < n_units_max; ++i) { pg8::Unit t; if (S.next(i, t)) { u1 = t; last = i; } }
    if (last == 0) u1 = u0;
    const int pmA = u0.pm, pmB = u1.pm;
    LAS float* tab = (LAS float*)(lds_base + RINV_OFF);
    const int row = (t_ < 256 ? pmA : pmB) * 256 + (t_ & 255);
    tab[t_] = rinv_row(ssq, row);
    __syncthreads();
    RinvTab R; R.pmA = pmA; R.pmB = pmB; R.tab = tab; R.ssq = ssq; return R;
}
__device__ __forceinline__ float rinv_get(const RinvTab& R, int pm, int r256) {
    if (pm == R.pmA) return R.tab[r256];
    if (pm == R.pmB) return R.tab[256 + r256];
    return rinv_row(R.ssq, pm * 256 + r256);
}
typedef float f32x2e __attribute__((ext_vector_type(2)));
__device__ __forceinline__ f32x2e sigmoid2(f32x2e a, float c) { const f32x2e z = a * c; f32x2e e; e.x = __builtin_amdgcn_exp2f(z.x); e.y = __builtin_amdgcn_exp2f(z.y); const f32x2e t = e + 1.0f; f32x2e s_; s_.x = __builtin_amdgcn_rcpf(t.x); s_.y = __builtin_amdgcn_rcpf(t.y); return s_; }
__device__ __forceinline__ unsigned pk_bf16x2(f32x2e v) { return pg8::cvt_pk_bf16(v.x, v.y); }
struct EpiSwiGLU {
    static constexpr bool PERM = true, AFTER_DRAIN = false;
    bf16* U; RinvTab R;
    __device__ __forceinline__ void operator()(const f32x4 (&acc)[2][2][4][2], const Unit& u, int wr, int wc, int fr, int fq) const {
        const int row0 = u.pm * BM + wr * 64 + fr, col0 = u.pn * 128 + wc * 32 + 8 * fq;
#pragma unroll
        for (int ai = 0; ai < 2; ++ai)
#pragma unroll
            for (int m = 0; m < 4; ++m) { const int row = row0 + ai * HALF + m * 16; const float r = rinv_get(R, u.pm, row & 255);
                const float c = -LOG2E * r, r2 = r * r;
                u32x4 w;
#pragma unroll
                for (int n = 0; n < 2; ++n) { const f32x4 g4 = acc[ai][0][m][n], u4 = acc[ai][1][m][n];
#pragma unroll
                    for (int h2 = 0; h2 < 2; ++h2) { const f32x2e g = (f32x2e){g4[2 * h2], g4[2 * h2 + 1]}, v = (f32x2e){u4[2 * h2], u4[2 * h2 + 1]};
                        const f32x2e a = g * c; f32x2e e; e.x = __builtin_amdgcn_exp2f(a.x); e.y = __builtin_amdgcn_exp2f(a.y);
                        const f32x2e t = e + 1.0f; f32x2e s; s.x = __builtin_amdgcn_rcpf(t.x); s.y = __builtin_amdgcn_rcpf(t.y);
                        const f32x2e h = (g * v) * (s * r2);
                        w[2 * n + h2] = pg8::cvt_pk_bf16(h.x, h.y); } }
                *(GAS u32x4*)(U + (size_t)row * DFF + col0) = w;
                if (m & 1) asm volatile("" ::: "memory"); }
    }
};
#ifndef RESID_NT
#define RESID_NT 0
#endif
struct EpiResid {
    static constexpr bool PERM = true, AFTER_DRAIN = false;
    float* xdst; bf16* xb; float* ssq; float coef;
    __device__ __forceinline__ void operator()(const f32x4 (&acc)[2][2][4][2], const Unit& u, int wr, int wc, int fr, int fq) const {
        const int row0 = u.pm * BM + wr * 64 + fr, col0 = u.pn * BM + wc * 32 + 8 * fq;
        u32x4 xin[2][4][2];
#pragma unroll
        for (int ai = 0; ai < 2; ++ai)
#pragma unroll
            for (int m = 0; m < 4; ++m)
#pragma unroll
                for (int bj = 0; bj < 2; ++bj) { const GAS u32x4* p_ = (const GAS u32x4*)(xb + (size_t)(row0 + ai * HALF + m * 16) * DM + col0 + bj * HALF); xin[ai][m][bj] = RESID_NT ? __builtin_nontemporal_load(p_) : *p_; }
        asm volatile("" ::: "memory");
#pragma unroll
        for (int ai = 0; ai < 2; ++ai)
#pragma unroll
            for (int m = 0; m < 4; ++m) { const int row = row0 + ai * HALF + m * 16; f32x2e sq2 = (f32x2e){0.f, 0.f};
#pragma unroll
                for (int bj = 0; bj < 2; ++bj) { const size_t off = (size_t)row * DM + col0 + bj * HALF;
                    const u32x4 xo = xin[ai][m][bj];
                    const f32x4 a0 = acc[ai][bj][m][0], a1 = acc[ai][bj][m][1];
                    const f32x2e y0 = (f32x2e){bf_lo(xo.x), bf_hi(xo.x)} + (f32x2e){a0[0], a0[1]} * coef, y1 = (f32x2e){bf_lo(xo.y), bf_hi(xo.y)} + (f32x2e){a0[2], a0[3]} * coef;
                    const f32x2e y2 = (f32x2e){bf_lo(xo.z), bf_hi(xo.z)} + (f32x2e){a1[0], a1[1]} * coef, y3 = (f32x2e){bf_lo(xo.w), bf_hi(xo.w)} + (f32x2e){a1[2], a1[3]} * coef;
                    if (xdst) { *(GAS f32x4*)(xdst + off) = (f32x4){y0.x, y0.y, y1.x, y1.y}; *(GAS f32x4*)(xdst + off + 4) = (f32x4){y2.x, y2.y, y3.x, y3.y}; }
                    u32x4 w; w.x = pk_bf16x2(y0); w.y = pk_bf16x2(y1); w.z = pk_bf16x2(y2); w.w = pk_bf16x2(y3);
                    *(GAS u32x4*)(xb + off) = w;
                    sq2 += y0 * y0; sq2 += y1 * y1; sq2 += y2 * y2; sq2 += y3 * y3; }
                float sq = sq2.x + sq2.y;
                sq += swz_xor<16>(sq); sq = add_xor32(sq);
                if (fq == 0) *(GAS float*)(ssq + (size_t)row * 16 + u.pn * 4 + wc) = sq;
                if (m & 1) asm volatile("" ::: "memory"); }
    }
};
struct EpiUpA {
    static constexpr bool PERM = true, AFTER_DRAIN = false;
    bf16* Y; const bf16* sg;
    __device__ __forceinline__ void operator()(const f32x4 (&acc)[2][2][4][2], const Unit& u, int wr, int wc, int fr, int fq) const {
        const int row0 = u.pm * BM + wr * 64 + fr, col0 = u.pn * BM + wc * 32 + 8 * fq;
#pragma unroll
        for (int ai = 0; ai < 2; ++ai)
#pragma unroll
            for (int m = 0; m < 4; ++m) { const int row = row0 + ai * HALF + m * 16;
#pragma unroll
                for (int bj = 0; bj < 2; ++bj) { const size_t off = (size_t)row * DM + col0 + bj * HALF;
                    const u32x4 a = *(const GAS u32x4*)(sg + off);
                    const f32x4 g0 = (f32x4){bf_lo(a.x), bf_hi(a.x), bf_lo(a.y), bf_hi(a.y)}, g1 = (f32x4){bf_lo(a.z), bf_hi(a.z), bf_lo(a.w), bf_hi(a.w)};
                    *(GAS u32x4*)(Y + off) = pack8(g0 * acc[ai][bj][m][0], g1 * acc[ai][bj][m][1]); }
                if (m & 1) asm volatile("" ::: "memory"); }
    }
};
struct EpiUpB {
    static constexpr bool PERM = true, AFTER_DRAIN = false;
    bf16* Y; const bf16* sg;
    __device__ __forceinline__ void operator()(const f32x4 (&acc)[2][2][4][2], const Unit& u, int wr, int wc, int fr, int fq) const {
        const int row0 = u.pm * BM + wr * 64 + fr, col0 = u.pn * BM + wc * 32 + 8 * fq;
#pragma unroll
        for (int ai = 0; ai < 2; ++ai)
#pragma unroll
            for (int m = 0; m < 4; ++m) { const int row = row0 + ai * HALF + m * 16;
#pragma unroll
                for (int bj = 0; bj < 2; ++bj) { const size_t off = (size_t)row * DM + col0 + bj * HALF;
                    const u32x4 a = *(const GAS u32x4*)(sg + off), t = *(const GAS u32x4*)(Y + off);
                    const f32x4 g0 = (f32x4){bf_lo(a.x), bf_hi(a.x), bf_lo(a.y), bf_hi(a.y)}, g1 = (f32x4){bf_lo(a.z), bf_hi(a.z), bf_lo(a.w), bf_hi(a.w)};
                    const f32x4 t0 = (f32x4){bf_lo(t.x), bf_hi(t.x), bf_lo(t.y), bf_hi(t.y)}, t1 = (f32x4){bf_lo(t.z), bf_hi(t.z), bf_lo(t.w), bf_hi(t.w)};
                    *(GAS u32x4*)(Y + off) = pack8(t0 + g0 * acc[ai][bj][m][0], t1 + g1 * acc[ai][bj][m][1]); }
                if (m & 1) asm volatile("" ::: "memory"); }
    }
};
struct EpiUp2 {
    static constexpr bool PERM = true, AFTER_DRAIN = false, MID_HOOK = true;
    bf16* Y; const unsigned char* sgn; const unsigned char* sgm;
    typedef unsigned u32x2v __attribute__((ext_vector_type(2)));
    static __device__ __forceinline__ void unpack8(u32x2v q, f32x4& lo, f32x4& hi) {
        lo = (f32x4){(float)(q.x & 0xffu), (float)((q.x >> 8) & 0xffu), (float)((q.x >> 16) & 0xffu), (float)(q.x >> 24)};
        hi = (f32x4){(float)(q.y & 0xffu), (float)((q.y >> 8) & 0xffu), (float)((q.y >> 16) & 0xffu), (float)(q.y >> 24)}; }
    __device__ __forceinline__ void mid(f32x4 (&acc)[2][2][4][2], const Unit& u, int wr, int wc, int fr, int fq) const {
        const int row0 = u.pm * BM + wr * 64 + fr, gcol = u.pn * BM + wc * 64 + 16 * fq;
#pragma unroll
        for (int ai = 0; ai < 2; ++ai) {
            u32x4 qa4[4], qb4[4];
#pragma unroll
            for (int m = 0; m < 4; ++m) { const size_t goff = (size_t)(row0 + ai * HALF + m * 16) * DM + gcol; qa4[m] = *(const GAS u32x4*)(sgn + goff); qb4[m] = *(const GAS u32x4*)(sgm + goff); }
            asm volatile("" ::: "memory");
#pragma unroll
            for (int m = 0; m < 4; ++m) {
                const u32x4 qa = qa4[m], qb = qb4[m];
#pragma unroll
                for (int bj = 0; bj < 2; ++bj) {
                    f32x4 a0, a1, b0, b1; unpack8(bj ? (u32x2v){qa.z, qa.w} : (u32x2v){qa.x, qa.y}, a0, a1); unpack8(bj ? (u32x2v){qb.z, qb.w} : (u32x2v){qb.x, qb.y}, b0, b1);
#pragma unroll
                    for (int e = 0; e < 4; ++e) { acc[ai][bj][m][0][e] *= a0[e] * __builtin_amdgcn_rcpf(b0[e]); acc[ai][bj][m][1][e] *= a1[e] * __builtin_amdgcn_rcpf(b1[e]); } } }
            asm volatile("" ::: "memory"); }
    }
    __device__ __forceinline__ void operator()(const f32x4 (&acc)[2][2][4][2], const Unit& u, int wr, int wc, int fr, int fq) const {
        const int row0 = u.pm * BM + wr * 64 + fr, col0 = u.pn * BM + wc * 32 + 8 * fq, gcol = u.pn * BM + wc * 64 + 16 * fq;
        u32x4 qb8[2][4];
#pragma unroll
        for (int ai = 0; ai < 2; ++ai)
#pragma unroll
            for (int m = 0; m < 4; ++m) qb8[ai][m] = *(const GAS u32x4*)(sgm + (size_t)(row0 + ai * HALF + m * 16) * DM + gcol);
        asm volatile("" ::: "memory");
#pragma unroll
        for (int ai = 0; ai < 2; ++ai)
#pragma unroll
            for (int m = 0; m < 4; ++m) { const int row = row0 + ai * HALF + m * 16;
                const u32x4 qb = qb8[ai][m];
#pragma unroll
                for (int bj = 0; bj < 2; ++bj) { const size_t off = (size_t)row * DM + col0 + bj * HALF;
                    f32x4 g0, g1; unpack8(bj ? (u32x2v){qb.z, qb.w} : (u32x2v){qb.x, qb.y}, g0, g1);
                    *(GAS u32x4*)(Y + off) = pack8(g0 * acc[ai][bj][m][0] * (1.0f / 255.0f), g1 * acc[ai][bj][m][1] * (1.0f / 255.0f)); }
                if (m & 1) asm volatile("" ::: "memory"); }
    }
};
struct EpiCmp1 {
    static constexpr bool PERM = true, AFTER_DRAIN = false;
    bf16* hid; const float* bias;
    __device__ __forceinline__ void operator()(const f32x4 (&acc)[2][2][4][2], const Unit& u, int wr, int wc, int fr, int fq) const {
        const int row0 = u.pm * BM + wr * 64 + fr, col0 = wc * 32 + 8 * fq;
#pragma unroll
        for (int ai = 0; ai < 2; ++ai)
#pragma unroll
            for (int m = 0; m < 4; ++m) { const int row = row0 + ai * HALF + m * 16;
#pragma unroll
                for (int bj = 0; bj < 2; ++bj) { f32x4 h[2];
#pragma unroll
                    for (int n = 0; n < 2; ++n) { const f32x4 v = acc[ai][bj][m][n] + *(const GAS f32x4*)(bias + col0 + bj * HALF + 4 * n);
#pragma unroll
                        for (int i = 0; i < 4; ++i) { const float x = v[i]; h[n][i] = x * fsigmoid(1.5957691216f * (x + 0.044715f * x * x * x)); } }
                    *(GAS u32x4*)(hid + (size_t)row * 256 + col0 + bj * HALF) = pack8(h[0], h[1]); }
                asm volatile("" ::: "memory"); }
    }
};
struct EpiCmp2 {
    static constexpr bool PERM = true, AFTER_DRAIN = false;
    bf16* dst; const float* g;
    __device__ __forceinline__ void operator()(const f32x4 (&acc)[2][2][4][2], const Unit& u, int wr, int wc, int fr, int fq) const {
        if (wc != 0) return;
        const int row0 = u.pm * BM + wr * 64 + fr;
#pragma unroll
        for (int ai = 0; ai < 2; ++ai)
#pragma unroll
            for (int m = 0; m < 4; ++m) { const int row = row0 + ai * HALF + m * 16;
                float ss = 0.f;
#pragma unroll
                for (int bj = 0; bj < 2; ++bj)
#pragma unroll
                    for (int n = 0; n < 2; ++n) ss += dot4(acc[ai][bj][m][n]);
                float hr = 1.0f;
                if (g) { ss += swz_xor<16>(ss); ss = add_xor32(ss); hr = 1.0f / sqrtf(ss * (1.0f / 64.0f) + 1e-6f); }
#pragma unroll
                for (int bj = 0; bj < 2; ++bj) { f32x4 v[2];
#pragma unroll
                    for (int n = 0; n < 2; ++n) { const f32x4 gvv = g ? *(const GAS f32x4*)(g + 32 * bj + 8 * fq + 4 * n) : (f32x4){1.f, 1.f, 1.f, 1.f}; v[n] = acc[ai][bj][m][n] * hr * gvv; }
                    *(GAS u32x4*)(dst + (size_t)row * 64 + 32 * bj + 8 * fq) = pack8(v[0], v[1]); }
                asm volatile("" ::: "memory"); }
    }
};
struct EpiWin {
    static constexpr bool PERM = true, AFTER_DRAIN = false;
    RinvTab R; bf16* Qn; bf16* Qm; bf16* KVH; bf16* SGN; bf16* SGM; float* GN; float* KMS; const float* gqn; const float* gqm;
    __device__ __forceinline__ void operator()(const f32x4 (&acc)[2][2][4][2], const Unit& u, int wr, int wc, int fr, int fq) const {
        const int pn = u.pn, row0 = u.pm * BM + wr * 64 + fr;
        if (pn >= 11 && pn <= 18) {
            unsigned char* dst = (unsigned char*)(pn < 15 ? SGN : SGM); const int col0 = 256 * ((pn - 11) & 3) + wc * 64 + 16 * fq;
#pragma unroll
            for (int ai = 0; ai < 2; ++ai)
#pragma unroll
                for (int m = 0; m < 4; ++m) { const int row = row0 + ai * HALF + m * 16; const float r = rinv_get(R, u.pm, row & 255);
                    const float c = -LOG2E * r; unsigned w[2][2];
#pragma unroll
                    for (int bj = 0; bj < 2; ++bj) {
#pragma unroll
                        for (int n = 0; n < 2; ++n) { const f32x4 a4 = acc[ai][bj][m][n];
                            const f32x2e s0 = sigmoid2((f32x2e){a4[0], a4[1]}, c) * 255.0f, s1 = sigmoid2((f32x2e){a4[2], a4[3]}, c) * 255.0f;
                            unsigned q = 0u; q = __builtin_amdgcn_cvt_pk_u8_f32(__builtin_fmaxf(s0.x, 1.0f), 0, q); q = __builtin_amdgcn_cvt_pk_u8_f32(__builtin_fmaxf(s0.y, 1.0f), 1, q);
                            q = __builtin_amdgcn_cvt_pk_u8_f32(__builtin_fmaxf(s1.x, 1.0f), 2, q); q = __builtin_amdgcn_cvt_pk_u8_f32(__builtin_fmaxf(s1.y, 1.0f), 3, q); w[bj][n] = q; } }
                    *(GAS u32x4*)(dst + (size_t)row * DM + col0) = (u32x4){w[0][0], w[0][1], w[1][0], w[1][1]};
                    if (m & 1) asm volatile("" ::: "memory"); }
            return;
        }
        if (pn == 19) {
            if (wc == 0 && fq < 3) {
#pragma unroll
                for (int ai = 0; ai < 2; ++ai)
#pragma unroll
                    for (int m = 0; m < 4; ++m) { const int row = row0 + ai * HALF + m * 16; const float r = rinv_get(R, u.pm, row & 255);
#pragma unroll
                        for (int n = 0; n < 2; ++n) { f32x4 s;
#pragma unroll
                            for (int i = 0; i < 4; ++i) s[i] = fsigmoid(acc[ai][0][m][n][i] * r);
                            *(GAS f32x4*)(GN + (size_t)row * 24 + 8 * fq + 4 * n) = s; } }
            }
            return;
        }
        const bool isq = (pn <= 1) || pn == 5 || pn == 6;
        bf16* base; size_t rstride; const float* g = nullptr; bool kmean = false; float oscale = 1.0f; int hm = 0;
        if (isq) { const int head = (pn <= 1 ? 4 * pn : 4 * (pn - 5)) + wc; base = (pn <= 1 ? Qn : Qm) + 64 * head; rstride = 512; g = pn <= 1 ? gqn : gqm; oscale = C2; }
        else { int slot;
            if (pn == 2) slot = wc; else if (pn == 3) { slot = 4 + wc; g = gqn + 64 * (2 + (wc >> 1)); } else if (pn == 4) slot = 8 + wc;
            else if (pn <= 8) { hm = 4 * (pn - 7) + wc; slot = 12 + hm; g = gqm + 64; kmean = true; } else slot = 20 + 4 * (pn - 9) + wc;
            base = KVH + (size_t)slot * M * 64; rstride = 64; }
        f32x4 gv[2][2], ks[2][2];
#pragma unroll
        for (int bj = 0; bj < 2; ++bj)
#pragma unroll
            for (int n = 0; n < 2; ++n) { gv[bj][n] = g ? *(const GAS f32x4*)(g + 32 * bj + 8 * fq + 4 * n) : (f32x4){1.f, 1.f, 1.f, 1.f}; ks[bj][n] = (f32x4){0.f, 0.f, 0.f, 0.f}; }
#pragma unroll
        for (int ai = 0; ai < 2; ++ai)
#pragma unroll
            for (int m = 0; m < 4; ++m) { const int row = row0 + ai * HALF + m * 16; const float r = rinv_get(R, u.pm, row & 255);
                f32x4 v[2][2]; f32x2e s2 = (f32x2e){0.f, 0.f};
#pragma unroll
                for (int bj = 0; bj < 2; ++bj)
#pragma unroll
                    for (int n = 0; n < 2; ++n) { const f32x4 a4 = acc[ai][bj][m][n]; const f32x2e lo = (f32x2e){a4[0], a4[1]}, hi = (f32x2e){a4[2], a4[3]}; s2 += lo * lo; s2 += hi * hi; }
                float sc = r;
                if (g) { float ss = (s2.x + s2.y) * (r * r); ss += swz_xor<16>(ss); ss = add_xor32(ss); sc = r * oscale / sqrtf(ss * (1.0f / 64.0f) + 1e-6f); }
#pragma unroll
                for (int bj = 0; bj < 2; ++bj)
#pragma unroll
                    for (int n = 0; n < 2; ++n) v[bj][n] = acc[ai][bj][m][n] * (gv[bj][n] * sc);
                if (kmean) {
#pragma unroll
                    for (int bj = 0; bj < 2; ++bj)
#pragma unroll
                        for (int n = 0; n < 2; ++n) ks[bj][n] += v[bj][n]; }
#pragma unroll
                for (int bj = 0; bj < 2; ++bj) *(GAS u32x4*)(base + (size_t)row * rstride + 32 * bj + 8 * fq) = pack8(v[bj][0], v[bj][1]);
                if (m & 1) asm volatile("" ::: "memory"); }
        if (kmean) {
            const int b = u.pm >> 3, nb = u.pm & 7; float* kd = KMS + (((size_t)b * 8 + hm) * 8 + nb) * 64;
#pragma unroll
            for (int bj = 0; bj < 2; ++bj)
#pragma unroll
                for (int n = 0; n < 2; ++n)
#pragma unroll
                    for (int i = 0; i < 4; ++i) { float s = ks[bj][n][i]; s += swz_xor<1>(s); s += swz_xor<2>(s); s += swz_xor<4>(s); s += swz_xor<8>(s);
                        if (fr == 0) __hip_atomic_fetch_add((GAS float*)(kd + 32 * bj + 8 * fq + 4 * n + i), s, __ATOMIC_RELAXED, __HIP_MEMORY_SCOPE_AGENT); }
        }
    }
};

struct Args { const float* in[14]; float* out; unsigned char* ws; int ph_lo, ph_hi, seq, prev_blocks; };
struct Frame {
    LAS unsigned char* lds; volatile LAS unsigned* MISC; gu32* ctl;
    int tid, lane, wave, vcu, G;
};


constexpr int CW_DONE = 8192;
__device__ __forceinline__ void launch_wait(gu32* ctl, int seq, int prev_blocks) {
    if (threadIdx.x == 0 && prev_blocks > 0) {
        unsigned sp = 0;
        while (__hip_atomic_load(ctl + CW_DONE + 64 * (seq - 1), __ATOMIC_RELAXED, __HIP_MEMORY_SCOPE_AGENT) < (unsigned)prev_blocks) { __builtin_amdgcn_s_sleep(2); if (++sp > (1u << 26)) break; }
        __builtin_amdgcn_fence(__ATOMIC_ACQUIRE, "agent"); asm volatile("s_waitcnt vmcnt(0)" ::: "memory");
    }
    __syncthreads();
}
__device__ __forceinline__ void launch_done(gu32* ctl, int seq) {
    asm volatile("s_waitcnt vmcnt(0)" ::: "memory"); __syncthreads();
    if (threadIdx.x == 0) { __builtin_amdgcn_fence(__ATOMIC_RELEASE, "agent"); asm volatile("s_waitcnt vmcnt(0)" ::: "memory");
        __hip_atomic_fetch_add(ctl + CW_DONE + 64 * seq, 1u, __ATOMIC_RELAXED, __HIP_MEMORY_SCOPE_AGENT); }
}
enum { MAP_ID = 0, MAP_GU = 1, MAP_HEAD = 2 };
struct Job { int src, soff, K, N, n0, nc, gsrc, goff, doff_kb  , Kd, kofs, map, mp; };
constexpr int NJOBS = 52;
struct JobTable { Job j[NJOBS]; int first[NJOBS + 1]; };
#ifndef PRO_WIDE
#define PRO_WIDE 0
#endif
#ifndef PRO_TALL
#define PRO_TALL 0
#endif
constexpr int PRO_KI = PRO_TALL ? 128 : (PRO_WIDE ? 32 : 64), PRO_NI = PRO_TALL ? 32 : (PRO_WIDE ? 128 : 64);
constexpr JobTable build_jobs() {
    JobTable T{}; int n = 0;
    for (int l = 0; l < 2; ++l) {
        for (int f = 0; f < 2; ++f) {
            const int nf = f == 0 ? 0 : 2, lf = l * 2 + f;
            T.j[n++] = Job{2, lf * DM * DFF, DM, DFF, 0, DFF, 1, (l * 3 + nf) * DM, (int)((WS_W13 + (size_t)lf * N13 * DM * 2) >> 10), DM, 0, MAP_GU, 0};
            T.j[n++] = Job{3, lf * DM * DFF, DM, DFF, 0, DFF, 1, (l * 3 + nf) * DM, (int)((WS_W13 + (size_t)lf * N13 * DM * 2) >> 10), DM, 0, MAP_GU, 128};
            T.j[n++] = Job{4, lf * DFF * DM, DFF, DM, 0, DM, -1, 0, (int)((WS_W2 + (size_t)lf * DM * DFF * 2) >> 10), DFF, 0, MAP_ID, 0};
        }
        const int so = l * DM * INC, go = (l * 3 + 1) * DM, dk = (int)((WS_WIN + (size_t)l * NIN * DM * 2) >> 10);
        T.j[n++] = Job{5, so, DM, INC, 0, 512, 1, go, dk, DM, 0, MAP_HEAD, 0};
        T.j[n++] = Job{5, so, DM, INC, 512, 128, 1, go, dk, DM, 0, MAP_HEAD, 8};
        T.j[n++] = Job{5, so, DM, INC, 640, 128, 1, go, dk, DM, 0, MAP_HEAD, 10};
        T.j[n++] = Job{5, so, DM, INC, 768, 128, 1, go, dk, DM, 0, MAP_HEAD, 12};
        T.j[n++] = Job{5, so, DM, INC, 896, 128, 1, go, dk, DM, 0, MAP_HEAD, 16};
        T.j[n++] = Job{5, so, DM, INC, 1024, 128, 1, go, dk, DM, 0, MAP_HEAD, 14};
        T.j[n++] = Job{5, so, DM, INC, 1152, 128, 1, go, dk, DM, 0, MAP_HEAD, 18};
        T.j[n++] = Job{5, so, DM, INC, 1280, 24, 1, go, dk, DM, 0, MAP_ID, 256 * 19};
        T.j[n++] = Job{5, so, DM, INC, 1304, 512, 1, go, dk, DM, 0, MAP_HEAD, 20};
        T.j[n++] = Job{5, so, DM, INC, 1816, 512, 1, go, dk, DM, 0, MAP_HEAD, 28};
        T.j[n++] = Job{5, so, DM, INC, 2328, 512, 1, go, dk, DM, 0, MAP_HEAD, 36};
        T.j[n++] = Job{5, so, DM, INC, 2840, 1024, 1, go, dk, DM, 0, MAP_ID, 256 * 11};
        T.j[n++] = Job{5, so, DM, INC, 3864, 1024, 1, go, dk, DM, 0, MAP_ID, 256 * 15};
        const int du = (int)((WS_WUP + (size_t)l * 2 * DM * 512 * 2) >> 10);
        T.j[n++] = Job{11, l * 512 * DM, 512, DM, 0, DM, -1, 0, du, DM, 0, MAP_ID, 0};
        T.j[n++] = Job{12, l * 512 * DM, 512, DM, 0, DM, -1, 0, du, DM, 512, MAP_ID, 0};
        T.j[n++] = Job{13, l * DM * DM, DM, DM, 0, DM, -1, 0, (int)((WS_WOUT + (size_t)l * DM * DM * 2) >> 10), DM, 0, MAP_ID, 0};
        for (int kv = 0; kv < 2; ++kv) {
            const int lk = l * 2 + kv;
            T.j[n++] = Job{9, lk * 2048 * 256, 2048, 256, 0, 256, -1, 0, (int)((WS_WC1 + (size_t)lk * 256 * 2048 * 2) >> 10), 2048, 0, MAP_ID, 0};
            T.j[n++] = Job{10, lk * 256 * 64, 256, 64, 0, 64, -1, 0, (int)((WS_WC2 + (size_t)lk * 256 * 256 * 2) >> 10), 256, 0, MAP_HEAD, 0};
        }
    }
    int tot = 0;
    for (int i = 0; i < NJOBS; ++i) { T.first[i] = tot; tot += (T.j[i].K / PRO_KI) * ((T.j[i].nc + PRO_NI - 1) / PRO_NI); }
    T.first[NJOBS] = tot;
    return T;
}
__device__ const JobTable JT = build_jobs();
__device__ __forceinline__ int map_row(int map, int mp, int x) {
    if (map == MAP_ID) return mp + x;
    if (map == MAP_GU) return 256 * (x >> 7) + (x & 127) + mp;
    const int hs = mp + (x >> 6), d = x & 63; return 256 * (hs >> 2) + 128 * (d >> 5) + 32 * (hs & 3) + (d & 31);
}
struct TrItem { const float* W; const float* gain; bf16* dst; int N, k0, nsrc0, ncv, Kd, kofs, map, mp, x0, nt; };
#ifndef PRO_NTST
#define PRO_NTST 1
#endif
typedef float f32x2t __attribute__((ext_vector_type(2)));
__device__ __forceinline__ void tr_load(const TrItem& t, f32x2t (&v)[32], f32x4 (&gq)[2], int lane) {
#ifndef PRO_PIPE
#define PRO_PIPE 0
#endif
    if (!PRO_PIPE) { if (t.gain) { const GAS f32x4* gp = (const GAS f32x4*)(t.gain + t.k0 + 8 * (lane & 7)); gq[0] = gp[0]; gq[1] = gp[1]; } else { gq[0] = (f32x4){1.f, 1.f, 1.f, 1.f}; gq[1] = gq[0]; } }
    const int c2 = lane & 31;
    if (t.ncv >= 64) {
#pragma unroll
#ifndef PRO_NT
#define PRO_NT 1
#endif
        for (int i = 0; i < 32; ++i) { const int kk = 2 * i + (lane >> 5); const GAS f32x2t* p_ = (const GAS f32x2t*)(t.W + (size_t)(t.k0 + kk) * t.N + t.nsrc0 + 2 * c2);
            v[i] = PRO_NT ? __builtin_nontemporal_load(p_) : *p_; }
    } else {
#pragma unroll
        for (int i = 0; i < 32; ++i) { const int kk = 2 * i + (lane >> 5); v[i] = (2 * c2 < t.ncv) ? *(const GAS f32x2t*)(t.W + (size_t)(t.k0 + kk) * t.N + t.nsrc0 + 2 * c2) : (f32x2t){0.f, 0.f}; }
    }
}
__device__ __forceinline__ void tr_gain(const TrItem& t, f32x4 (&gq)[2], int lane) {
    if (t.gain) { const GAS f32x4* gp = (const GAS f32x4*)(t.gain + t.k0 + 8 * (lane & 7)); gq[0] = gp[0]; gq[1] = gp[1]; } else { gq[0] = (f32x4){1.f, 1.f, 1.f, 1.f}; gq[1] = gq[0]; }
}
__device__ __forceinline__ void tr_finish(const TrItem& t, const f32x2t (&v)[32], const f32x4 (&gq)[2], LAS float* scr, int lane) {
    const int c2 = lane & 31;
#pragma unroll
    for (int i = 0; i < 32; ++i) { const int kk = 2 * i + (lane >> 5); *(LAS f32x2t*)(scr + kk * 64 + ((2 * c2) ^ (kk & 62))) = v[i]; }
    LDS_WAIT(); asm volatile("" ::: "memory");
    const int c8 = lane & 7;
#pragma unroll
    for (int j = 0; j < 8; ++j) { const int n = (lane >> 3) + 8 * j;
        float e[8];
#pragma unroll
        for (int q = 0; q < 8; ++q) { const int kk = 8 * c8 + q; e[q] = scr[kk * 64 + (n ^ (kk & 62))] * gq[q >> 2][q & 3]; }
        v4u o; o.x = pg8::cvt_pk_bf16(e[0], e[1]); o.y = pg8::cvt_pk_bf16(e[2], e[3]); o.z = pg8::cvt_pk_bf16(e[4], e[5]); o.w = pg8::cvt_pk_bf16(e[6], e[7]);
        if (n < t.ncv) { GAS v4u* p_ = (GAS v4u*)(t.dst + (size_t)map_row(t.map, t.mp, t.x0 + n) * t.Kd + t.kofs + t.k0 + 8 * c8); if (t.nt) __builtin_nontemporal_store(o, p_); else *p_ = o; } }
    LDS_WAIT(); asm volatile("" ::: "memory");
}
__device__ __forceinline__ void trw_load(const TrItem& t, f32x4 (&w)[16], f32x4 (&gq)[2], int lane) {
    if (t.gain) { const GAS f32x4* gp = (const GAS f32x4*)(t.gain + t.k0 + 8 * (lane & 3)); gq[0] = gp[0]; gq[1] = gp[1]; } else { gq[0] = (f32x4){1.f, 1.f, 1.f, 1.f}; gq[1] = gq[0]; }
    const int c4 = lane & 31, rh = lane >> 5;
    if (t.ncv >= 128) {
#pragma unroll
        for (int i = 0; i < 16; ++i) { const int kk = 2 * i + rh; w[i] = *(const GAS f32x4*)(t.W + (size_t)(t.k0 + kk) * t.N + t.nsrc0 + 4 * c4); }
    } else {
#pragma unroll
        for (int i = 0; i < 16; ++i) { const int kk = 2 * i + rh; w[i] = (4 * c4 < t.ncv) ? *(const GAS f32x4*)(t.W + (size_t)(t.k0 + kk) * t.N + t.nsrc0 + 4 * c4) : (f32x4){0.f, 0.f, 0.f, 0.f}; }
    }
}
__device__ __forceinline__ void trw_finish(const TrItem& t, const f32x4 (&w)[16], const f32x4 (&gq)[2], LAS float* scr, int lane) {
    const int c4 = lane & 31, rh = lane >> 5;
#pragma unroll
    for (int i = 0; i < 16; ++i) { const int kk = 2 * i + rh; *(LAS f32x4*)(scr + kk * 128 + ((4 * c4) ^ (((kk >> 3) & 3) << 3))) = w[i]; }
    LDS_WAIT(); asm volatile("" ::: "memory");
    const int ch = lane & 3, nl = lane >> 2;
#pragma unroll
    for (int j = 0; j < 8; ++j) { const int n = nl + 16 * j;
        float e[8];
#pragma unroll
        for (int q = 0; q < 8; ++q) { const int kk = 8 * ch + q; e[q] = scr[kk * 128 + (n ^ (ch << 3))] * gq[q >> 2][q & 3]; }
        v4u o; o.x = pg8::cvt_pk_bf16(e[0], e[1]); o.y = pg8::cvt_pk_bf16(e[2], e[3]); o.z = pg8::cvt_pk_bf16(e[4], e[5]); o.w = pg8::cvt_pk_bf16(e[6], e[7]);
        if (n < t.ncv) *(GAS v4u*)(t.dst + (size_t)map_row(t.map, t.mp, t.x0 + n) * t.Kd + t.kofs + t.k0 + 8 * ch) = o; }
    LDS_WAIT(); asm volatile("" ::: "memory");
}
__device__ __forceinline__ void trt_load(const TrItem& t, f32x2t (&v)[32], f32x4 (&gq)[2], int lane) {
    if (t.gain) { const GAS f32x4* gp = (const GAS f32x4*)(t.gain + t.k0 + 8 * (lane & 15)); gq[0] = gp[0]; gq[1] = gp[1]; } else { gq[0] = (f32x4){1.f, 1.f, 1.f, 1.f}; gq[1] = gq[0]; }
    const int c2 = lane & 15, r4 = lane >> 4;
    if (t.ncv >= 32) {
#pragma unroll
        for (int i = 0; i < 32; ++i) { const int kk = 4 * i + r4; v[i] = *(const GAS f32x2t*)(t.W + (size_t)(t.k0 + kk) * t.N + t.nsrc0 + 2 * c2); }
    } else {
#pragma unroll
        for (int i = 0; i < 32; ++i) { const int kk = 4 * i + r4; v[i] = (2 * c2 < t.ncv) ? *(const GAS f32x2t*)(t.W + (size_t)(t.k0 + kk) * t.N + t.nsrc0 + 2 * c2) : (f32x2t){0.f, 0.f}; }
    }
}
__device__ __forceinline__ void trt_finish(const TrItem& t, const f32x2t (&v)[32], const f32x4 (&gq)[2], LAS float* scr, int lane) {
    const int c2 = lane & 15, r4 = lane >> 4;
#pragma unroll
    for (int i = 0; i < 32; ++i) { const int kk = 4 * i + r4; *(LAS f32x2t*)(scr + kk * 32 + ((2 * c2) ^ (((kk >> 3) & 15) << 1))) = v[i]; }
    LDS_WAIT(); asm volatile("" ::: "memory");
    const int ch = lane & 15, nl = lane >> 4;
#pragma unroll
    for (int j = 0; j < 8; ++j) { const int n = nl + 4 * j;
        float e[8];
#pragma unroll
        for (int q = 0; q < 8; ++q) { const int kk = 8 * ch + q; e[q] = scr[kk * 32 + (n ^ (ch << 1))] * gq[q >> 2][q & 3]; }
        v4u o; o.x = pg8::cvt_pk_bf16(e[0], e[1]); o.y = pg8::cvt_pk_bf16(e[2], e[3]); o.z = pg8::cvt_pk_bf16(e[4], e[5]); o.w = pg8::cvt_pk_bf16(e[6], e[7]);
        if (n < t.ncv) *(GAS v4u*)(t.dst + (size_t)map_row(t.map, t.mp, t.x0 + n) * t.Kd + t.kofs + t.k0 + 8 * ch) = o; }
    LDS_WAIT(); asm volatile("" ::: "memory");
}
__device__ __forceinline__ const float* in_ptr(const Args& a, int i) {
    const float* p = a.in[0];
    p = i == 1 ? a.in[1] : p; p = i == 2 ? a.in[2] : p; p = i == 3 ? a.in[3] : p; p = i == 4 ? a.in[4] : p; p = i == 5 ? a.in[5] : p; p = i == 9 ? a.in[9] : p;
    p = i == 10 ? a.in[10] : p; p = i == 11 ? a.in[11] : p; p = i == 12 ? a.in[12] : p; p = i == 13 ? a.in[13] : p; return p;
}
__device__ __forceinline__ float wave_sum(float v) {
    v += swz_xor<1>(v); v += swz_xor<2>(v); v += swz_xor<4>(v); v += swz_xor<8>(v); v += swz_xor<16>(v); v = add_xor32(v);
    return v;
}
__device__ __forceinline__ void p0_prologue(Frame& F, const Args& a) {
    LAS float* scr = (LAS float*)(F.lds + RING_OFF + F.wave * 16384);
    const int gw = F.vcu * NWAVES + F.wave, NGW = F.G * NWAVES;
    unsigned char* ws = a.ws;
    const int total = JT.first[NJOBS];
    LAS int* jt_l = (LAS int*)(F.lds + RING_OFF + 8 * 16384 - 4096);
    (void)jt_l;
    auto mk = [&](int it) { TrItem t;
        int ji = 0;
        for (int q = 1; q < NJOBS; ++q) ji = (it >= JT.first[q]) ? q : ji;
        const Job jb = JT.j[ji]; const int r = it - JT.first[ji];
#ifndef PRO_KFAST
#define PRO_KFAST 0
#endif
        const int nblk = (jb.nc + PRO_NI - 1) / PRO_NI, nkb = jb.K / PRO_KI, kb = PRO_KFAST ? r % nkb : r / nblk, nb = PRO_KFAST ? r / nkb : r % nblk;
        t.W = in_ptr(a, jb.src) + jb.soff; t.N = jb.N; t.k0 = PRO_KI * kb; t.nsrc0 = jb.n0 + PRO_NI * nb; t.ncv = (jb.nc - PRO_NI * nb) < PRO_NI ? (jb.nc - PRO_NI * nb) : PRO_NI;
        t.gain = jb.gsrc >= 0 ? a.in[1] + jb.goff : nullptr; t.dst = (bf16*)(ws + ((size_t)jb.doff_kb << 10)); t.Kd = jb.Kd; t.kofs = jb.kofs; t.map = jb.map; t.mp = jb.mp; t.x0 = PRO_NI * nb; t.nt = (PRO_NTST && ji >= NJOBS / 2) ? 1 : 0;
        return t; };
#ifndef PRO_PIPE
#define PRO_PIPE 0
#endif
#ifndef PRO_FUSE
#define PRO_FUSE 0
#endif
#if PRO_FUSE
    { const float* x = a.in[0]; bf16* xb = (bf16*)(ws + WS_XB); float* ssq = (float*)(ws + WS_SSQ);
      constexpr int XR = 2; int it = gw, m0 = XR * gw;
#pragma unroll 1
      while (it < total || m0 < M) {
          const bool hi_ = it < total, hx_ = m0 < M;
          f32x2t v0[32]; f32x4 g0[2]; f32x4 v[XR][4]; TrItem t0;
          if (hi_) { t0 = mk(it); tr_load(t0, v0, g0, F.lane); }
          if (hx_) {
#pragma unroll
              for (int rr = 0; rr < XR; ++rr) { const GAS f32x4* xr = (const GAS f32x4*)(x + (size_t)(m0 + rr) * DM) + F.lane;
#pragma unroll
                  for (int j = 0; j < 4; ++j) v[rr][j] = xr[64 * j]; } }
          if (hi_) tr_finish(t0, v0, g0, scr, F.lane);
          if (hx_) {
#pragma unroll
              for (int rr = 0; rr < XR; ++rr) { float s = 0.f;
#pragma unroll
                  for (int j = 0; j < 4; ++j) s += dot4(v[rr][j]);
                  s = wave_sum(s);
                  GAS unsigned long long* o8 = (GAS unsigned long long*)(xb + (size_t)(m0 + rr) * DM) + F.lane;
#pragma unroll
                  for (int j = 0; j < 4; ++j) o8[64 * j] = (unsigned long long)pg8::cvt_pk_bf16(v[rr][j][0], v[rr][j][1]) | ((unsigned long long)pg8::cvt_pk_bf16(v[rr][j][2], v[rr][j][3]) << 32);
                  if (F.lane < 16) ssq[(size_t)(m0 + rr) * 16 + F.lane] = F.lane == 0 ? s : 0.f; } }
          it += NGW; m0 += XR * NGW; } }
#else
#if PRO_PIPE
    { int it = gw;
      if (it < total) { f32x2t va[32], vb[32]; f32x4 gq[2], gdum[2]; TrItem ta = mk(it); tr_load(ta, va, gdum, F.lane);
#pragma unroll 1
          for (;;) {
              const int i1 = it + NGW; const bool h1 = i1 < total; TrItem tb = ta;
              tr_gain(ta, gq, F.lane);
              if (h1) { tb = mk(i1); tr_load(tb, vb, gdum, F.lane); }
              tr_finish(ta, va, gq, scr, F.lane);
              if (!h1) break;
              const int i2 = i1 + NGW; const bool h2 = i2 < total;
              tr_gain(tb, gq, F.lane);
              if (h2) { ta = mk(i2); tr_load(ta, va, gdum, F.lane); }
              tr_finish(tb, vb, gq, scr, F.lane);
              if (!h2) break;
              it = i2; } } }
#else
    for (int it = gw; it < total; it += NGW) {
#if PRO_TALL
        const TrItem t0 = mk(it); f32x2t v0[32]; f32x4 g0[2];
        trt_load(t0, v0, g0, F.lane);
        trt_finish(t0, v0, g0, scr, F.lane);
#elif PRO_WIDE
        const TrItem t0 = mk(it); f32x4 w0[16]; f32x4 g0[2];
        trw_load(t0, w0, g0, F.lane);
        trw_finish(t0, w0, g0, scr, F.lane);
#else
        const TrItem t0 = mk(it); f32x2t v0[32]; f32x4 g0[2];
        tr_load(t0, v0, g0, F.lane);
        tr_finish(t0, v0, g0, scr, F.lane);
#endif
    }
#endif
#endif
#define PRO_STAMP(n) do { } while (0)
    PRO_STAMP(1);
    const int gt = F.vcu * (NWAVES * 64) + F.tid, GT = F.G * NWAVES * 64; const v4u z = {0u, 0u, 0u, 0u};
    for (int i = gt; i < 2 * 232 * 128; i += GT) { const int l = i / (232 * 128), r = i % (232 * 128); *(GAS v4u*)(ws + WS_WIN + (size_t)l * NIN * DM * 2 + (size_t)(19 * 256 + 24 + r / 128) * 2048 + (r % 128) * 16) = z; }
    for (int i = gt; i < 4 * 256 * 32; i += GT) { const int lk = i / (256 * 32), r = (i / 32) % 256, c = i % 32;
        if ((r & 127) >= 32) *(GAS v4u*)(ws + WS_WC2 + (size_t)lk * 256 * 256 * 2 + (size_t)r * 512 + c * 16) = z; }
    for (int i = gt; i < 2 * 16 * 8 * 8 * 64 / 4; i += GT) *(GAS v4u*)(ws + WS_KMS + (size_t)i * 16) = z;
#if !PRO_FUSE
    { const float* x = a.in[0]; bf16* xb = (bf16*)(ws + WS_XB); float* ssq = (float*)(ws + WS_SSQ);
      for (int m0 = 4 * gw; m0 < M; m0 += 4 * NGW) { f32x4 v[4][4];
#pragma unroll
          for (int rr = 0; rr < 4; ++rr) { const GAS f32x4* xr = (const GAS f32x4*)(x + (size_t)(m0 + rr) * DM) + F.lane;
#pragma unroll
              for (int j = 0; j < 4; ++j) v[rr][j] = PRO_NT ? __builtin_nontemporal_load(xr + 64 * j) : xr[64 * j]; }
#pragma unroll
          for (int rr = 0; rr < 4; ++rr) { float s = 0.f;
#pragma unroll
              for (int j = 0; j < 4; ++j) s += dot4(v[rr][j]);
              s = wave_sum(s);
              GAS unsigned long long* o8 = (GAS unsigned long long*)(xb + (size_t)(m0 + rr) * DM) + F.lane;
#pragma unroll
              for (int j = 0; j < 4; ++j) o8[64 * j] = (unsigned long long)pg8::cvt_pk_bf16(v[rr][j][0], v[rr][j][1]) | ((unsigned long long)pg8::cvt_pk_bf16(v[rr][j][2], v[rr][j][3]) << 32);
              if (F.lane < 16) ssq[(size_t)(m0 + rr) * 16 + F.lane] = F.lane == 0 ? s : 0.f; } } }
#endif
    PRO_STAMP(2);
    for (int w = blockIdx.x; w < 64; w += F.G) {
        const int lk = w >> 4, cg = w & 15, col = cg * 16 + (F.tid & 15), ks = F.tid >> 4;
        const float* pos = a.in[8] + (size_t)lk * 2048 + ks * 64; const float* w1 = a.in[9] + (size_t)lk * 2048 * 256 + (size_t)(ks * 64) * 256 + col;
        float s = 0.f;
#pragma unroll 16
        for (int k = 0; k < 64; ++k) s += pos[k] * w1[(size_t)k * 256];
        LAS float* red = (LAS float*)(F.lds + RING_OFF);
        __syncthreads();
        red[F.tid] = s;
        __syncthreads();
        if (F.tid < 16) { float t = 0.f;
#pragma unroll
            for (int q = 0; q < 32; ++q) t += red[q * 16 + F.tid];
            ((float*)(ws + WS_BC1))[lk * 256 + cg * 16 + F.tid] = t; }
        __syncthreads();
    }
}

namespace att {
typedef float f32x16 __attribute__((ext_vector_type(16)));
typedef short bf16x8 __attribute__((ext_vector_type(8)));
typedef short s16x4 __attribute__((ext_vector_type(4)));
constexpr int NBUF = 5, TILEB = 16384;
constexpr int L_RING = 0, L_WSCR = NBUF * TILEB, L_IMP = L_WSCR + 8 * 256, L_SELM = L_IMP + 64 * 32 * 4, L_WUN = L_SELM + 256, L_QSLOT = L_WUN + 32, L_KMEAN = L_WUN + 64,
              L_RAW = L_KMEAN + 8 * 64 * 4, L_ILV = L_RAW + 64 * 4 * 32 * 4, L_END = L_ILV + 64 * 4 * 4;
static_assert(L_END <= RING_BYTES, "attention LDS map");
constexpr float NEG_INF_F = -__builtin_huge_valf();

#define LDS_BARRIER() do { asm volatile("s_waitcnt lgkmcnt(0)" ::: "memory"); __builtin_amdgcn_s_barrier(); asm volatile("" ::: "memory"); } while (0)
struct Lane {
    int lane, r32, hi;
    int vb0, vb1;
    int kof[4];
    int dko, dvo;
};
__device__ __forceinline__ Lane make_lane(int lane, int wave) {
    Lane L; L.lane = lane; L.r32 = lane & 31; L.hi = lane >> 5;
    const int g1 = (lane >> 4) & 1, q = (lane & 15) >> 2, p = lane & 3, sw = (q >> 1) & 1;
    const int base = (4 * L.hi + q) * 128 + 32 * g1 + 8 * p;
    L.vb0 = base + 64 * sw; L.vb1 = base + 64 * (1 - sw);
#pragma unroll
    for (int d0 = 0; d0 < 4; ++d0) L.kof[d0] = L.r32 * 128 + (((2 * d0 + L.hi) ^ ((L.r32 >> 1) & 7)) << 4);
    const int row = 8 * wave + (lane >> 3), cp = lane & 7;
    L.dko = row * 64 + ((cp ^ ((row >> 1) & 7)) << 3); L.dvo = row * 64 + ((cp ^ (((row >> 1) & 1) << 2)) << 3);
    return L;
}
__device__ __forceinline__ void dma_tile(LAS unsigned char* buf, const bf16* Kt, const bf16* Vt, const Lane& L, int wave) {
    const unsigned lk = (unsigned)(size_t)(buf + wave * 1024), lv = lk + 8192u;
    const bf16* kp = Kt + L.dko; const bf16* vp = Vt + L.dvo;
    unsigned sv;
    asm volatile("s_mov_b32 %0, m0\n\ts_mov_b32 m0, %3\n\ts_nop 0\n\tglobal_load_lds_dwordx4 %1, off\n\ts_mov_b32 m0, %4\n\ts_nop 0\n\tglobal_load_lds_dwordx4 %2, off\n\ts_mov_b32 m0, %0"
                 : "=&s"(sv) : "v"(kp), "v"(vp), "s"(lk), "s"(lv) : "memory");
}
__device__ __forceinline__ void wait_tiles_ahead(int ahead) {
    if (ahead <= 0) asm volatile("s_waitcnt vmcnt(0)" ::: "memory");
    else if (ahead == 1) asm volatile("s_waitcnt vmcnt(2)" ::: "memory");
    else if (ahead == 2) asm volatile("s_waitcnt vmcnt(4)" ::: "memory");
    else if (ahead == 3) asm volatile("s_waitcnt vmcnt(6)" ::: "memory");
    else asm volatile("s_waitcnt vmcnt(8)" ::: "memory");
}
__device__ __forceinline__ unsigned cvtpk(float lo, float hi) { return pg8::cvt_pk_bf16(lo, hi); }
#ifndef TS_BATCH
#define TS_BATCH 0
#endif
#ifndef MOBA_BATCH
#define MOBA_BATCH 1
#endif
#ifndef NSA_BATCH
#define NSA_BATCH 1
#endif
#ifndef TS_UNPACK
#define TS_UNPACK 1
#endif
#if TS_UNPACK
#define TS_PIN(v) asm volatile("" : "+v"(v))
#else
#define TS_PIN(v) do {} while (0)
#endif
template <bool LEAN = false, bool BATCH = (TS_BATCH != 0)>
__device__ __forceinline__ void tile_step(LAS const unsigned char* kb, LAS const unsigned char* vb, const bf16x8 (&qf)[4], const Lane& L, float slopeK, float x,
                                          bool need_causal, int kq, bool need_win, int kwin, int jbase, f32x16 (&o)[2], float& l, f32x16& p0, f32x16& p1) {
#pragma unroll
    for (int r = 0; r < 16; ++r) { const float kc = (float)((r & 3) + 8 * (r >> 2)); float a = __builtin_fmaf(slopeK, kc, x); TS_PIN(a); p0[r] = a; float b = __builtin_fmaf(slopeK, kc + 32.0f, x); TS_PIN(b); p1[r] = b; }
if constexpr (BATCH) {
    bf16x8 kf0[4], kf1[4];
#pragma unroll
    for (int d0 = 0; d0 < 4; ++d0) kf0[d0] = *(LAS const bf16x8*)(kb + L.kof[d0]);
    if constexpr (!LEAN) {
#pragma unroll
        for (int d0 = 0; d0 < 4; ++d0) kf1[d0] = *(LAS const bf16x8*)(kb + 4096 + L.kof[d0]); }
#pragma unroll
    for (int d0 = 0; d0 < 4; ++d0) p0 = __builtin_amdgcn_mfma_f32_32x32x16_bf16(kf0[d0], qf[d0], p0, 0, 0, 0);
    if constexpr (LEAN) {
        __builtin_amdgcn_sched_barrier(0);
#pragma unroll
        for (int d0 = 0; d0 < 4; ++d0) kf1[d0] = *(LAS const bf16x8*)(kb + 4096 + L.kof[d0]); }
#pragma unroll
    for (int d0 = 0; d0 < 4; ++d0) p1 = __builtin_amdgcn_mfma_f32_32x32x16_bf16(kf1[d0], qf[d0], p1, 0, 0, 0);
} else {
#pragma unroll
    for (int d0 = 0; d0 < 4; ++d0) { const bf16x8 k0 = *(LAS const bf16x8*)(kb + L.kof[d0]); p0 = __builtin_amdgcn_mfma_f32_32x32x16_bf16(k0, qf[d0], p0, 0, 0, 0); }
#pragma unroll
    for (int d0 = 0; d0 < 4; ++d0) { const bf16x8 k1 = *(LAS const bf16x8*)(kb + 4096 + L.kof[d0]); p1 = __builtin_amdgcn_mfma_f32_32x32x16_bf16(k1, qf[d0], p1, 0, 0, 0); }
}
    float ssum = 0.f;
#pragma unroll
    for (int u = 0; u < 2; ++u) {
        f32x16& p = u ? p1 : p0;
        bf16x8 vf[2][2];
if constexpr (BATCH) {
#pragma unroll
        for (int s = 0; s < (LEAN ? 1 : 2); ++s)
#pragma unroll
            for (int db = 0; db < 2; ++db) { LAS const unsigned char* va = vb + (db ? L.vb1 : L.vb0) + (32 * u + 16 * s) * 128;
                const s16x4 lo = __builtin_bit_cast(s16x4, __builtin_amdgcn_ds_read_tr16_b64_v4i16((LAS s16x4*)(va)));
                const s16x4 hh = __builtin_bit_cast(s16x4, __builtin_amdgcn_ds_read_tr16_b64_v4i16((LAS s16x4*)(va + 8 * 128)));
                vf[s][db] = (bf16x8){lo[0], lo[1], lo[2], lo[3], hh[0], hh[1], hh[2], hh[3]}; }
}
        const int kb0 = jbase + 32 * u + 4 * L.hi;
        if (need_causal) {
#pragma unroll
            for (int r = 0; r < 16; ++r) { const int kv = kb0 + (r & 3) + 8 * (r >> 2); p[r] = kv > kq ? NEG_INF_F : p[r]; } }
        if (need_win) {
#pragma unroll
            for (int r = 0; r < 16; ++r) { const int kv = kb0 + (r & 3) + 8 * (r >> 2); p[r] = kv <= kwin ? NEG_INF_F : p[r]; } }
        float s0 = 0.f, s1 = 0.f;
#pragma unroll
        for (int r = 0; r < 16; r += 2) { const float e0 = __builtin_amdgcn_exp2f(p[r]), e1 = __builtin_amdgcn_exp2f(p[r + 1]); p[r] = e0; p[r + 1] = e1; s0 += e0; TS_PIN(s0); s1 += e1; TS_PIN(s1); }
        ssum += s0 + s1;
        unsigned pw[8];
#pragma unroll
        for (int i = 0; i < 8; ++i) pw[i] = cvtpk(p[2 * i], p[2 * i + 1]);
#pragma unroll
        for (int s = 0; s < 2; ++s) {
            u32x4 pa; pa.x = pw[4 * s]; pa.y = pw[4 * s + 1]; pa.z = pw[4 * s + 2]; pa.w = pw[4 * s + 3];
            const bf16x8 af = __builtin_bit_cast(bf16x8, pa);
if constexpr (BATCH) {
#pragma unroll
            for (int db = 0; db < 2; ++db) o[db] = __builtin_amdgcn_mfma_f32_32x32x16_bf16(af, vf[LEAN ? 0 : s][db], o[db], 0, 0, 0);
            if constexpr (LEAN) { if (s == 0) {
#pragma unroll
                for (int db = 0; db < 2; ++db) { LAS const unsigned char* va = vb + (db ? L.vb1 : L.vb0) + (32 * u + 16) * 128;
                    const s16x4 lo = __builtin_bit_cast(s16x4, __builtin_amdgcn_ds_read_tr16_b64_v4i16((LAS s16x4*)(va)));
                    const s16x4 hh = __builtin_bit_cast(s16x4, __builtin_amdgcn_ds_read_tr16_b64_v4i16((LAS s16x4*)(va + 8 * 128)));
                    vf[0][db] = (bf16x8){lo[0], lo[1], lo[2], lo[3], hh[0], hh[1], hh[2], hh[3]}; } } }
} else {
            const int roff = (32 * u + 16 * s) * 128;
#pragma unroll
            for (int db = 0; db < 2; ++db) { LAS const unsigned char* va = vb + (db ? L.vb1 : L.vb0) + roff;
                const s16x4 lo = __builtin_bit_cast(s16x4, __builtin_amdgcn_ds_read_tr16_b64_v4i16((LAS s16x4*)(va)));
                const s16x4 hh = __builtin_bit_cast(s16x4, __builtin_amdgcn_ds_read_tr16_b64_v4i16((LAS s16x4*)(va + 8 * 128)));
                const bf16x8 bfv = (bf16x8){lo[0], lo[1], lo[2], lo[3], hh[0], hh[1], hh[2], hh[3]};
                o[db] = __builtin_amdgcn_mfma_f32_32x32x16_bf16(af, bfv, o[db], 0, 0, 0); }
}
        }
    }
    l += ssum;
}
struct Ring { unsigned mi, mc, mi2, mc2; int issued, computed, ib, cb; };
__device__ __forceinline__ void ring_init(Ring& R, unsigned firstmask, int b0 = 0) { R.mi = R.mc = firstmask; R.mi2 = R.mc2 = 0u; R.issued = R.computed = 0; R.ib = R.cb = b0; }
__device__ __forceinline__ bool ring_issue(Ring& R, LAS unsigned char* lds, const bf16* Kb, const bf16* Vb, const bf16* Kb2, const bf16* Vb2, const Lane& L, int wave) {
    const bool first = R.mi != 0u;
    unsigned& m = first ? R.mi : R.mi2;
    if (m == 0u) return false;
    const int jn = __builtin_ctz(m); m &= m - 1u;
    dma_tile(lds + L_RING + R.ib * TILEB, (first ? Kb : Kb2) + (size_t)jn * 4096, (first ? Vb : Vb2) + (size_t)jn * 4096, L, wave); ++R.issued; R.ib = (R.ib + 1 == NBUF) ? 0 : R.ib + 1;
    return true;
}
#ifndef PAIRS
#define PAIRS 1
#endif
#if PAIRS
template <bool MOBA, bool WIN, int PART>
__device__ __forceinline__ void attn_consume(Ring& R, LAS unsigned char* lds, int wave, const bf16* Kb, const bf16* Vb, const bf16* Kb2, const bf16* Vb2, unsigned rowmask, const bf16x8 (&qf)[4], const Lane& L,
                                             float slopeK, float xconst, int kq, int kq_min, int kq_max, int kwin, int kwin_max, f32x16 (&o)[2], float& l) {
    if (PART != 2) {
#pragma unroll 1
        while (R.issued - R.computed < NBUF - 1) { if (!ring_issue(R, lds, Kb, Vb, Kb2, Vb2, L, wave)) break; } }
    f32x16 p0, p1;
#pragma unroll 1
    while (PART == 1 ? R.mc : (R.mc | R.mc2)) {
#ifndef TGROUP
#define TGROUP 2
#endif
        int jj[TGROUP]; int cnt = 0;
#pragma unroll
        for (int t = 0; t < TGROUP; ++t) { if (PART == 1 ? R.mc : (R.mc | R.mc2)) { unsigned& m = (PART == 1 || R.mc) ? R.mc : R.mc2; jj[t] = __builtin_ctz(m); m &= m - 1u; ++cnt; } else jj[t] = 0; }
        wait_tiles_ahead(R.issued - R.computed - cnt);
        LDS_BARRIER();
#pragma unroll 1
        while (R.issued - R.computed < NBUF) { if (!ring_issue(R, lds, Kb, Vb, Kb2, Vb2, L, wave)) break; }
#pragma unroll 1
        for (int t = 0; t < cnt; ++t) {
            const int j = (TGROUP > 2 && t == 2) ? jj[TGROUP - 1] : (t ? jj[1] : jj[0]);
            const int jbase = 64 * j;
            const bool en = (rowmask >> (MOBA ? (j >> 2) : j)) & 1u;
            if (jbase <= kq_max && __ballot(en) != 0ull) {
                const float x = en ? __builtin_fmaf(slopeK, (float)(jbase + 4 * L.hi), xconst) : NEG_INF_F;
                int cbt = R.cb + t; cbt = cbt >= NBUF ? cbt - NBUF : cbt;
                LAS const unsigned char* tb = lds + L_RING + cbt * TILEB;
                tile_step<WIN, (MOBA ? (MOBA_BATCH != 0) : (NSA_BATCH != 0))>(tb, tb + 8192, qf, L, slopeK, x, (jbase + 63) > kq_min, kq, WIN && (jbase <= kwin_max), kwin, jbase, o, l, p0, p1);
            }
        }
        R.computed += cnt; R.cb += cnt; R.cb = R.cb >= NBUF ? R.cb - NBUF : R.cb;
    }
    if (PART != 1) LDS_BARRIER();
}
#endif
__device__ __forceinline__ void row_scales(LAS float* wscr, const Lane& L, float sc, float (&out)[16]) {
    if (L.hi == 0) wscr[L.r32] = sc;
    asm volatile("s_waitcnt lgkmcnt(0)" ::: "memory");
#pragma unroll
    for (int r = 0; r < 16; ++r) out[r] = wscr[(r & 3) + 8 * (r >> 2) + 4 * L.hi];
    asm volatile("s_waitcnt lgkmcnt(0)" ::: "memory");
}
__device__ __forceinline__ void load_q(bf16x8 (&qf)[4], const bf16* qrow, int hi) {
#pragma unroll
    for (int d0 = 0; d0 < 4; ++d0) qf[d0] = *(const GAS bf16x8*)(qrow + 16 * d0 + 8 * hi);
}

__device__ __forceinline__ void moba_unit(LAS unsigned char* lds, int tid_unused, int wave, int b, int h, int n, const bf16* Qm, const bf16* KVH, const float* KMS, bf16* OC) {
    int lane_v; asm volatile("v_mbcnt_lo_u32_b32 %0, -1, 0\n\tv_mbcnt_hi_u32_b32 %0, -1, %0" : "=v"(lane_v));
    const int tid = wave * 64 + lane_v; (void)tid_unused;
    const Lane L = make_lane(lane_v, wave);
    const int t_q = 256 * n + 32 * wave + L.r32, row = b * SEQ + t_q;
    const bf16* Kh = KVH + ((size_t)(12 + h) * M + (size_t)b * SEQ) * 64; const bf16* Vh = KVH + ((size_t)(20 + h) * M + (size_t)b * SEQ) * 64;
#ifndef MOBA_ASMLD
#define MOBA_ASMLD 0
#endif
    bf16x8 qf[4]; float kmv;
#if MOBA_ASMLD
    { const bf16* qrow = Qm + (size_t)row * 512 + 64 * h + 8 * L.hi; const float* kp_ = KMS + ((size_t)b * 8 + h) * 8 * 64 + tid;
#pragma unroll
      for (int d0 = 0; d0 < 4; ++d0) asm volatile("global_load_dwordx4 %0, %1, off" : "=&v"(qf[d0]) : "v"(qrow + 16 * d0) : "memory");
      asm volatile("global_load_dword %0, %1, off" : "=&v"(kmv) : "v"(kp_) : "memory"); }
#else
    load_q(qf, Qm + (size_t)row * 512 + 64 * h, L.hi);
    kmv = *(const GAS float*)(KMS + ((size_t)b * 8 + h) * 8 * 64 + tid);
#endif
    Ring R; ring_init(R, 0xFu << (4 * n));
#pragma unroll 1
    for (int k = 0; k < NBUF - 1; ++k) (void)ring_issue(R, lds, Kh, Vh, Kh, Vh, L, wave);
    LAS float* km = (LAS float*)(lds + L_KMEAN);
#if MOBA_ASMLD
    asm volatile("s_waitcnt vmcnt(8)" : "+v"(qf[0]), "+v"(qf[1]), "+v"(qf[2]), "+v"(qf[3]), "+v"(kmv) :: "memory");
#endif
    km[tid] = kmv;
    LDS_BARRIER();
    unsigned blocks = 0u;
    { float gate[8];
#pragma unroll
      for (int nb = 0; nb < 8; ++nb) { float s = 0.f;
#pragma unroll
          for (int d0 = 0; d0 < 4; ++d0) { const u32x4 qq = __builtin_bit_cast(u32x4, qf[d0]); const LAS float* kp = km + nb * 64 + 16 * d0 + 8 * L.hi;
              s += bf_lo(qq.x) * kp[0] + bf_hi(qq.x) * kp[1] + bf_lo(qq.y) * kp[2] + bf_hi(qq.y) * kp[3] + bf_lo(qq.z) * kp[4] + bf_hi(qq.z) * kp[5] + bf_lo(qq.w) * kp[6] + bf_hi(qq.w) * kp[7]; }
          s = add_xor32(s); gate[nb] = s; }
      unsigned sel = 0u;
#pragma unroll
      for (int k = 0; k < 3; ++k) { float best = -3.0e38f; int bi = -1;
#pragma unroll
          for (int nb = 0; nb < 8; ++nb) { const bool ok = (nb < n) && !((sel >> nb) & 1u) && gate[nb] > best; best = ok ? gate[nb] : best; bi = ok ? nb : bi; }
          if (bi >= 0) sel |= 1u << bi; }
      blocks = sel | (1u << n); }
    unsigned wun = 0u;
#pragma unroll
    for (int nb = 0; nb < 8; ++nb) wun |= (__ballot((blocks >> nb) & 1u) != 0ull) ? (1u << nb) : 0u;
    LAS unsigned* wu = (LAS unsigned*)(lds + L_WUN);
    if ((tid & 63) == 0) wu[wave] = wun;
    LDS_BARRIER();
    unsigned un = 0u;
#pragma unroll
    for (int w = 0; w < 8; ++w) un |= wu[w];
    unsigned pastmask = 0u;
#pragma unroll
    for (int nb = 0; nb < 8; ++nb) pastmask |= (((un >> nb) & 1u) && nb != n) ? (0xFu << (4 * nb)) : 0u;
    R.mi2 = R.mc2 = pastmask;
    const float slope2 = __builtin_amdgcn_exp2f(-(float)(h + 1)) * LOG2E;
    const int tmin = 256 * n + 32 * wave, tmax = tmin + 31;
    f32x16 o[2]; o[0] = (f32x16){}; o[1] = (f32x16){}; float lsum = 0.f;
    attn_consume<true, false, 0>(R, lds, wave, Kh, Vh, Kh, Vh, blocks, qf, L, slope2, -slope2 * (float)t_q, t_q, tmin, tmax, 0, 0, o, lsum);
    lsum = add_xor32(lsum);
    float sc[16]; row_scales((LAS float*)(lds + L_WSCR + wave * 256), L, 1.0f / lsum, sc);
    { LAS unsigned short* stg = (LAS unsigned short*)(lds + L_RING + wave * 4096);
      int lo_ = L.r32; asm volatile("" : "+v"(lo_));
#pragma unroll
      for (int r = 0; r < 16; ++r) { const int q = (r & 3) + 8 * (r >> 2) + 4 * L.hi;
          stg[q * 64 + lo_] = (unsigned short)(pg8::cvt_pk_bf16(o[0][r] * sc[r], 0.f) & 0xffffu); stg[q * 64 + 32 + lo_] = (unsigned short)(pg8::cvt_pk_bf16(o[1][r] * sc[r], 0.f) & 0xffffu); }
      asm volatile("s_waitcnt lgkmcnt(0)" ::: "memory");
      bf16* ob = OC + (size_t)(b * SEQ + 256 * n + 32 * wave) * DM + 512 + 64 * h;
#pragma unroll
      for (int i = 0; i < 4; ++i) { const int row = 8 * i + (L.lane >> 3), ch = L.lane & 7;
          const u32x4 v = *(LAS const u32x4*)((LAS const unsigned char*)stg + i * 1024 + L.lane * 16);
          *(GAS u32x4*)(ob + (size_t)row * DM + 8 * ch) = v; } }
    LDS_BARRIER();
}
__device__ __forceinline__ int queue_first(LAS unsigned char* lds, unsigned* counter, bool lane0) {
    LAS int* slot = (LAS int*)(lds + L_QSLOT);
    if (lane0) *slot = (int)__hip_atomic_fetch_add((GAS unsigned*)counter, 1u, __ATOMIC_RELAXED, __HIP_MEMORY_SCOPE_AGENT);
    __syncthreads();
    const int u = *slot;
    __syncthreads();
    return u;
}
__device__ __forceinline__ int queue_request(unsigned* counter, bool lane0) { int r = 0; if (lane0) r = (int)__hip_atomic_fetch_add((GAS unsigned*)counter, 1u, __ATOMIC_RELAXED, __HIP_MEMORY_SCOPE_AGENT); return r; }
__device__ __forceinline__ int queue_publish(LAS unsigned char* lds, int r, bool lane0) {
    LAS int* slot = (LAS int*)(lds + L_QSLOT);
    if (lane0) *slot = r;
    LDS_BARRIER();
    const int u = *slot;
    LDS_BARRIER();
    return u;
}
__device__ __forceinline__ int queue_find(LAS unsigned char* lds, unsigned* counters, int q, int tid) {
    LAS int* snap = (LAS int*)(lds + L_WUN);
    if (tid < 8) snap[tid] = (int)__hip_atomic_load((GAS unsigned*)(counters + 64 * tid), __ATOMIC_RELAXED, __HIP_MEMORY_SCOPE_AGENT);
    __syncthreads();
    int r = -1;
#pragma unroll
    for (int s = 7; s >= 1; --s) { const int qq = (q + s) & 7; r = (snap[qq] < 128) ? qq : r; }
    __syncthreads();
    return r;
}
#ifndef XCD_QUEUES
#define XCD_QUEUES 0
#endif
__device__ __forceinline__ void moba_phase(LAS unsigned char* lds, int tid, int wave, int vcu, int G, unsigned char* ws, int l, bf16* OC, int qidx) {
    const bf16* Qm = (const bf16*)(ws + WS_QM); const bf16* KVH = (const bf16*)(ws + WS_KVH);
    const float* KMS = (const float*)(ws + WS_KMS) + (size_t)l * 16 * 8 * 8 * 64;
    (void)vcu; (void)G;
#if XCD_QUEUES
    unsigned* counters = (unsigned*)(ws + WS_CTL) + CW_QUEUE + 64 * 8 * qidx;
    int q = (int)(xb_xcc_id() & 7u);
    int u = queue_first(lds, counters + 64 * q, tid == 0);
    for (;;) {
        while (u >= 128) { q = queue_find(lds, counters, q, tid); if (q < 0) return; u = queue_first(lds, counters + 64 * q, tid == 0); }
        const int nxt = queue_request(counters + 64 * q, tid == 0);
        const int n = 7 - ((u >> 2) & 7), b = 4 * (u >> 5) + (u & 3);
        moba_unit(lds, tid, wave, b, q, n, Qm, KVH, KMS, OC);
        u = queue_publish(lds, nxt, tid == 0);
    }
#else
    unsigned* counter = (unsigned*)(ws + WS_CTL) + CW_QUEUE + 64 * 8 * qidx;
    int u = queue_first(lds, counter, tid == 0);
    while (u < 1024) {
        const int nxt = queue_request(counter, tid == 0);
        const int n = 7 - (u >> 7), bh = u & 127;
        moba_unit(lds, tid, wave, bh >> 3, bh & 7, n, Qm, KVH, KMS, OC);
        u = queue_publish(lds, nxt, tid == 0);
    }
#endif
}

__device__ __forceinline__ void nsa_unit(LAS unsigned char* lds, int tid_unused, int wave, int b, int g, int cur, const bf16* Qn, const bf16* KVH, const bf16* CK, const bf16* CV, const float* GN, bf16* OC) {
    int lane_v; asm volatile("v_mbcnt_lo_u32_b32 %0, -1, 0\n\tv_mbcnt_hi_u32_b32 %0, -1, %0" : "=v"(lane_v));
    const int tid = wave * 64 + lane_v; (void)tid_unused;
    const Lane L = make_lane(lane_v, wave);
    const int t0 = 64 * cur, tl = L.r32 >> 2, hd = L.r32 & 3, hn = 4 * g + hd;
    const int t_q = t0 + 8 * wave + tl, row = b * SEQ + t_q;
#ifndef NSA_ASMLD
#define NSA_ASMLD 0
#endif
    bf16x8 qf[4]; float g0, g1, g2;
#if NSA_ASMLD
    { const bf16* qrow = Qn + (size_t)row * 512 + 64 * hn + 8 * L.hi; const float* gp_ = GN + (size_t)row * 24 + hn * 3;
#pragma unroll
      for (int d0 = 0; d0 < 4; ++d0) asm volatile("global_load_dwordx4 %0, %1, off" : "=&v"(qf[d0]) : "v"(qrow + 16 * d0) : "memory");
      asm volatile("global_load_dword %0, %1, off" : "=&v"(g0) : "v"(gp_) : "memory");
      asm volatile("global_load_dword %0, %1, off offset:4" : "=&v"(g1) : "v"(gp_) : "memory");
      asm volatile("global_load_dword %0, %1, off offset:8" : "=&v"(g2) : "v"(gp_) : "memory"); }
#else
    load_q(qf, Qn + (size_t)row * 512 + 64 * hn, L.hi);
    { const GAS float* gp = (const GAS float*)(GN + (size_t)row * 24 + hn * 3); g0 = gp[0]; g1 = gp[1]; g2 = gp[2]; }
#endif
    const float slope2 = __builtin_amdgcn_exp2f(-((float)hn + 0.5f)) * LOG2E;
    LAS float* wscr = (LAS float*)(lds + L_WSCR + wave * 256);
    f32x16 ot[2]; ot[0] = (f32x16){}; ot[1] = (f32x16){};
    f32x16 o[2]; float lsum; float sc[16];
    const int tmin = t0 + 8 * wave, tmax = tmin + 7;
    unsigned rowmask;
    const unsigned causal_tiles = (cur >= 31) ? 0xFFFFFFFFu : ((2u << cur) - 1u);
    const bf16* Ks = KVH + ((size_t)(4 + g) * M + (size_t)b * SEQ) * 64; const bf16* Vs = KVH + ((size_t)(8 + g) * M + (size_t)b * SEQ) * 64;
    const bf16* Kw = KVH + ((size_t)(6 + g) * M + (size_t)b * SEQ) * 64; const bf16* Vw = KVH + ((size_t)(10 + g) * M + (size_t)b * SEQ) * 64;
    Ring R;
    {
        const int cq = (t_q - 31) >> 4;
        const int cq_min = (tmin - 31) >> 4, cq_max = (tmax - 31) >> 4;
        const int maxc = (t0 + 63 - 31) >> 4;
        const int ntile = (maxc >> 6) + 1;
        const float slopeK = 16.0f * slope2, xconst = slope2 * (15.5f - (float)t_q);
        const bf16* Kc = CK + ((size_t)(g * 16 + b) * 128) * 64; const bf16* Vc = CV + ((size_t)(g * 16 + b) * 128) * 64;
        o[0] = (f32x16){}; o[1] = (f32x16){}; lsum = 0.f;
        LAS float* raw = (LAS float*)(lds + L_RAW);
        LAS float* ilv = (LAS float*)(lds + L_ILV);
        const int ts = 8 * wave + tl;
        LAS float* rawp = raw + (ts * 4 + hd) * 32;
        dma_tile(lds + L_RING, Kc, Vc, L, wave);
        if (ntile > 1) dma_tile(lds + L_RING + TILEB, Kc + 4096, Vc + 4096, L, wave);
        ring_init(R, ((cur >= 8) ? (0x1FFu << (cur - 8)) : causal_tiles) & causal_tiles, 2);
#pragma unroll 1
        for (int k = 0; k < 3; ++k) (void)ring_issue(R, lds, Kw, Vw, Ks, Vs, L, wave);
        wait_tiles_ahead(R.issued);
#if NSA_ASMLD
        asm volatile("" : "+v"(qf[0]), "+v"(qf[1]), "+v"(qf[2]), "+v"(qf[3]), "+v"(g0), "+v"(g1), "+v"(g2) :: "memory");
#endif
        LDS_BARRIER();
        float carry = 0.f;
#pragma unroll
        for (int i = 0; i < 2; ++i) {
            if (i < ntile) {
                f32x16 p0, p1;
                const float x = __builtin_fmaf(slopeK, (float)(64 * i + 4 * L.hi), xconst);
                tile_step<false, (NSA_BATCH != 0)>(lds + L_RING + i * TILEB, lds + L_RING + i * TILEB + 8192, qf, L, slopeK, x, true, cq, false, 0, 64 * i, o, lsum, p0, p1);
                float Bprev = carry;
#pragma unroll
                for (int k2 = 0; k2 < 8; ++k2) {
                    const float q0 = k2 < 4 ? p0[4 * k2] : p1[4 * (k2 - 4)], q1 = k2 < 4 ? p0[4 * k2 + 1] : p1[4 * (k2 - 4) + 1], q2 = k2 < 4 ? p0[4 * k2 + 2] : p1[4 * (k2 - 4) + 2], q3 = k2 < 4 ? p0[4 * k2 + 3] : p1[4 * (k2 - 4) + 3];
                    const float Bq = 0.5f * q3, pB = get_xor32(Bq, L.hi);
                    const float add = L.hi ? pB : Bprev;
                    rawp[16 * i + 2 * k2 + L.hi] = (q0 + q1) + (q2 + Bq) + add;
                    Bprev = pB;
                }
                carry = Bprev;
            }
        }
        (void)cq_min; (void)cq_max;
        lsum = add_xor32(lsum);
        const float il = lsum > 0.f ? 1.0f / lsum : 0.f;
        if (L.hi == 0) ilv[ts * 4 + hd] = il;
        row_scales(wscr, L, g0 * il, sc);
#pragma unroll
        for (int r = 0; r < 16; ++r) { ot[0][r] = o[0][r] * sc[r]; ot[1][r] = o[1][r] * sc[r]; }
        asm volatile("s_waitcnt lgkmcnt(0)" ::: "memory");
        LAS float* imp = (LAS float*)(lds + L_IMP);
#pragma unroll 1
        for (int pass = 0; pass < 4; ++pass) {
            const int tsp = 8 * wave + 2 * pass + (L.lane >> 5), jj = L.lane & 31;
            float v = 0.f;
#pragma unroll
            for (int hh = 0; hh < 4; ++hh) v += raw[(tsp * 4 + hh) * 32 + jj] * ilv[tsp * 4 + hh];
            imp[tsp * 32 + jj] = (jj == 0 || jj == cur || jj == cur - 1) ? 1.0e9f : (jj <= cur ? v : -1.0e30f);
        }
        asm volatile("s_waitcnt lgkmcnt(0)" ::: "memory");
        unsigned wun = 0u;
        LAS unsigned* selm = (LAS unsigned*)(lds + L_SELM);
#pragma unroll 1
        for (int pass = 0; pass < 4; ++pass) {
            const int tsp = 8 * wave + 2 * pass + (L.lane >> 5), jj = L.lane & 31;
            const LAS float* rowp = imp + tsp * 32;
            const float my = rowp[jj]; int rank = 0;
#pragma unroll
            for (int j4 = 0; j4 < 8; ++j4) { const f32x4 vv = *(const LAS f32x4*)(rowp + 4 * j4);
#pragma unroll
                for (int e = 0; e < 4; ++e) { const int jo = 4 * j4 + e; rank += (vv[e] > my || (vv[e] == my && jo < jj)) ? 1 : 0; } }
            const unsigned long long bal = __ballot(rank < 8);
            const unsigned lo = (unsigned)bal, hi32 = (unsigned)(bal >> 32);
            if (L.lane == 0) { selm[8 * wave + 2 * pass] = lo; selm[8 * wave + 2 * pass + 1] = hi32; }
            wun |= lo | hi32;
        }
        LAS unsigned* wu = (LAS unsigned*)(lds + L_WUN);
        if (L.lane == 0) wu[wave] = wun;
        __syncthreads();
        rowmask = selm[ts];
    }
    unsigned un = 0u;
    { LAS unsigned* wu = (LAS unsigned*)(lds + L_WUN);
#pragma unroll
      for (int w = 0; w < 8; ++w) un |= wu[w]; }
    R.mi2 = R.mc2 = un & causal_tiles;
    o[0] = (f32x16){}; o[1] = (f32x16){}; lsum = 0.f;
    LAS float* stash = (LAS float*)(lds + RINV_OFF) + tid;
#pragma unroll
    for (int k = 0; k < 7; ++k) stash[k * 512] = ot[1][9 + k];
    attn_consume<false, true, 1>(R, lds, wave, Kw, Vw, Ks, Vs, 0xFFFFFFFFu, qf, L, slope2, -slope2 * (float)t_q, t_q, tmin, tmax, t_q - 512, tmax - 512, o, lsum);
    lsum = add_xor32(lsum);
#pragma unroll
    for (int k = 0; k < 7; ++k) ot[1][9 + k] = stash[k * 512];
    row_scales(wscr, L, g2 / lsum, sc);
#pragma unroll
    for (int r = 0; r < 16; ++r) { ot[0][r] += o[0][r] * sc[r]; ot[1][r] += o[1][r] * sc[r]; }
    o[0] = (f32x16){}; o[1] = (f32x16){}; lsum = 0.f;
    attn_consume<false, false, 2>(R, lds, wave, Kw, Vw, Ks, Vs, rowmask, qf, L, slope2, -slope2 * (float)t_q, t_q, tmin, tmax, 0, 0, o, lsum);
    lsum = add_xor32(lsum);
    row_scales(wscr, L, g1 / lsum, sc);
#pragma unroll
    for (int r = 0; r < 16; ++r) { ot[0][r] += o[0][r] * sc[r]; ot[1][r] += o[1][r] * sc[r]; }
    { LAS unsigned short* stg = (LAS unsigned short*)(lds + L_RING + wave * 4096);
      int lo_ = L.r32; asm volatile("" : "+v"(lo_));
#pragma unroll
      for (int r = 0; r < 16; ++r) { const int q = (r & 3) + 8 * (r >> 2) + 4 * L.hi; const int so = (q >> 2) * 256 + (q & 3) * 64;
          stg[so + lo_] = (unsigned short)(pg8::cvt_pk_bf16(ot[0][r], 0.f) & 0xffffu); stg[so + 32 + lo_] = (unsigned short)(pg8::cvt_pk_bf16(ot[1][r], 0.f) & 0xffffu); }
      asm volatile("s_waitcnt lgkmcnt(0)" ::: "memory");
      bf16* ob = OC + (size_t)(b * SEQ + t0 + 8 * wave) * DM + 256 * g;
#pragma unroll
      for (int i = 0; i < 4; ++i) { const int tok = 2 * i + (L.lane >> 5), cb8 = L.lane & 31;
          const u32x4 v = *(LAS const u32x4*)((LAS const unsigned char*)stg + i * 1024 + L.lane * 16);
          *(GAS u32x4*)(ob + (size_t)tok * DM + 8 * cb8) = v; } }
    LDS_BARRIER();
}
__device__ __forceinline__ void nsa_phase(LAS unsigned char* lds, int tid, int wave, int vcu, int G, unsigned char* ws, int l, bf16* OC, int qidx) {
    const bf16* Qn = (const bf16*)(ws + WS_QN); const bf16* KVH = (const bf16*)(ws + WS_KVH);
    const bf16* CK = (const bf16*)(ws + WS_CMP); const bf16* CV = CK + (size_t)4096 * 64; const float* GN = (const float*)(ws + WS_GN);
    (void)vcu; (void)G;
#if XCD_QUEUES
    unsigned* counters = (unsigned*)(ws + WS_CTL) + CW_QUEUE + 64 * 8 * qidx;
    int q = (int)(xb_xcc_id() & 7u);
    int u = queue_first(lds, counters + 64 * q, tid == 0);
    for (;;) {
        while (u >= 128) { q = queue_find(lds, counters, q, tid); if (q < 0) return; u = queue_first(lds, counters + 64 * q, tid == 0); }
        const int nxt = queue_request(counters + 64 * q, tid == 0);
        const int cur = 31 - (u >> 2), bg = q + 8 * (u & 3);
        nsa_unit(lds, tid, wave, bg >> 1, bg & 1, cur, Qn, KVH, CK, CV, GN, OC);
        u = queue_publish(lds, nxt, tid == 0);
    }
#else
    unsigned* counter = (unsigned*)(ws + WS_CTL) + CW_QUEUE + 64 * 8 * qidx;
    int u = queue_first(lds, counter, tid == 0);
    while (u < 1024) {
        const int nxt = queue_request(counter, tid == 0);
        const int cur = 31 - (u >> 5), bg = u & 31;
        nsa_unit(lds, tid, wave, bg >> 1, bg & 1, cur, Qn, KVH, CK, CV, GN, OC);
        u = queue_publish(lds, nxt, tid == 0);
    }
#endif
}
}

typedef const char __attribute__((address_space(4))) kconst_char;
__device__ __forceinline__ unsigned char* ws_reload() {
    kconst_char* ka = (kconst_char*)__builtin_amdgcn_kernarg_segment_ptr();
    return (unsigned char*)(*(const volatile unsigned long long __attribute__((address_space(4)))*)(ka + 120));
}
template <class T> __device__ __forceinline__ T* opq_ptr(T* p) { const unsigned long long v = (unsigned long long)p; unsigned lo = __builtin_amdgcn_readfirstlane((unsigned)v), hi = __builtin_amdgcn_readfirstlane((unsigned)(v >> 32)); asm volatile("" : "+s"(lo), "+s"(hi)); return (T*)(((unsigned long long)hi << 32) | lo); }
__device__ __forceinline__ int OPQ(int v) { asm volatile("" : "+s"(v)); return v; }
constexpr int N_PHASES = 19;
#ifndef RUN_PHASES
#define RUN_PHASES N_PHASES
#endif
#ifndef PHMASK
#define PHMASK 0x3ff
#endif
#define EN(k) (((PHMASK) >> (k)) & 1)
#define RPT_COEF(ph, c) (c)
#define PROBE_LAST 0
#ifndef G2_AUX
#define G2_AUX 0
#endif
#ifndef G1_ALIGN
#define G1_ALIGN 1
#endif
#ifndef RESID_ALIGN
#define RESID_ALIGN 1
#endif
__global__ void __launch_bounds__(NWAVES * 64, 2) fwd_kernel(Args args) {
    extern __shared__ __attribute__((aligned(16))) unsigned char lds[];
    Frame F;
    F.lds = (LAS unsigned char*)lds;
    F.MISC = nullptr;
    F.tid = threadIdx.x; F.lane = F.tid & 63; F.wave = __builtin_amdgcn_readfirstlane(F.tid >> 6);
    F.G = gridDim.x; { const int bx = blockIdx.x; F.vcu = (F.G % 8 == 0) ? (bx % 8) * (F.G / 8) + bx / 8 : bx; }
    F.ctl = (gu32*)(opq_ptr(args.ws) + WS_CTL);
    for (int u = F.tid; u < (LDS_BYTES - LDSCTL_OFF) / 4; u += NWAVES * 64) ((LAS unsigned*)(F.lds + LDSCTL_OFF))[u] = 0u;
    __syncthreads();
    if (MK_ONE_LAUNCH) (void)xcd_barrier_post((unsigned*)(opq_ptr(args.ws) + WS_CTL) + CW_BAR + args.seq * 16384, (volatile LAS unsigned*)(F.lds + MISC_OFF) + 8);
    if (!MK_ONE_LAUNCH) launch_wait((gu32*)(opq_ptr(args.ws) + WS_CTL), args.seq, args.prev_blocks);
    const int lo = args.ph_lo, hi = args.ph_hi;
#define IN(k) (lo <= (k) && (k) < hi)
#define TSTAMP(k) do { } while (0)
#define TARRIVE(k) do { } while (0)
#define SEAM(k) do { TARRIVE(k); if (MK_ONE_LAUNCH && IN(k) && (IN((k) + 1) || PROBE_LAST)) { XcdBarrier b_; b_.bar = (unsigned*)(opq_ptr(args.ws) + WS_CTL) + CW_BAR + args.seq * 16384; b_.x = xb_xcc_id(); b_.st = (volatile LAS unsigned*)(F.lds + MISC_OFF) + 8; xcd_barrier(b_, F.wave); } TSTAMP((k) + 1); } while (0)
#define XB ((bf16*)(opq_ptr(args.ws) + WS_XB))
#define SSQ ((float*)(opq_ptr(args.ws) + WS_SSQ))
#define U ((bf16*)(opq_ptr(args.ws) + WS_U))
#define xout (opq_ptr(args.out))

    TSTAMP(0);
    if (EN(9) && IN(0)) { p0_prologue(F, args); SEAM(0); }

    for (int l = 0; l < DEPTH; ++l) {
        const int pb = 1 + 9 * l;
        if (EN(0) && IN(pb + 0)) {
            pg8::Gemm g{XB, (const bf16*)(opq_ptr(args.ws) + WS_W13) + (size_t)(l * 2 + 0) * N13 * DM, M, N13, DM, DM}; pg8::StaticOrder S; S.init(M, N13, OPQ(F.G), OPQ((int)blockIdx.x));
            EpiSwiGLU E{U, rinv_fill(F.lds, SSQ, S, 11, F.wave)};
            pg8::gemm_phase<EpiSwiGLU, pg8::StaticOrder, (G1_ALIGN != 0), true>(F.lds + RING_OFF, g, S, E, F.wave);
            SEAM(pb + 0);
        }
        if (EN(1) && IN(pb + 1)) {
            pg8::Gemm g{U, (const bf16*)(opq_ptr(args.ws) + WS_W2) + (size_t)(l * 2 + 0) * DM * DFF, M, DM, DFF, DFF}; pg8::StaticOrder S; S.init(M, DM, OPQ(F.G), OPQ((int)blockIdx.x));
            EpiResid E{nullptr, XB, SSQ, 0.5f};
            pg8::gemm_phase<EpiResid, pg8::StaticOrder, (RESID_ALIGN != 0), true, G2_AUX>(F.lds + RING_OFF, g, S, E, F.wave);
            SEAM(pb + 1);
        }
        if (EN(2) && IN(pb + 2)) {
            pg8::Gemm g{XB, (const bf16*)(opq_ptr(args.ws) + WS_WIN) + (size_t)l * NIN * DM, M, NIN, DM, DM}; pg8::StaticOrder S; S.init(M, NIN, OPQ(F.G), OPQ((int)blockIdx.x));
            EpiWin E{rinv_fill(F.lds, SSQ, S, 10, F.wave), (bf16*)(opq_ptr(args.ws) + WS_QN), (bf16*)(opq_ptr(args.ws) + WS_QM), (bf16*)(opq_ptr(args.ws) + WS_KVH), (bf16*)(opq_ptr(args.ws) + WS_SGN), (bf16*)(opq_ptr(args.ws) + WS_SGM), (float*)(opq_ptr(args.ws) + WS_GN),
                     (float*)(opq_ptr(args.ws) + WS_KMS) + (size_t)l * 16 * 8 * 8 * 64, opq_ptr(args.in[6]) + (size_t)l * 4 * 64, opq_ptr(args.in[7]) + (size_t)l * 2 * 64};
            pg8::gemm_phase<EpiWin, pg8::StaticOrder, true, true>(F.lds + RING_OFF, g, S, E, F.wave);
            SEAM(pb + 2);
        }
        if (EN(3) && IN(pb + 3)) {
#pragma unroll 1
            for (int kv = 0; kv < 2; ++kv) {
                const int cshift = (int)((blockIdx.x + (kv ? F.G / 2 : 0)) % F.G);
                bf16* hid = (bf16*)(opq_ptr(args.ws) + WS_HID) + (size_t)kv * 4096 * 256;
                { pg8::Gemm g{(const bf16*)(opq_ptr(args.ws) + WS_KVH) + (size_t)(2 * kv) * M * 64, (const bf16*)(opq_ptr(args.ws) + WS_WC1) + (size_t)(l * 2 + kv) * 256 * 2048, 4096, 256, 2048, 1024};
                  pg8::StaticOrder S; S.init(4096, 256, OPQ(F.G), OPQ(cshift));
                  EpiCmp1 E{hid, (const float*)(opq_ptr(args.ws) + WS_BC1) + (l * 2 + kv) * 256};
                  pg8::gemm_phase<EpiCmp1, pg8::StaticOrder, true, true>(F.lds + RING_OFF, g, S, E, F.wave); }
                VM_WAIT(); __syncthreads();
                { pg8::Gemm g{hid, (const bf16*)(opq_ptr(args.ws) + WS_WC2) + (size_t)(l * 2 + kv) * 256 * 256, 4096, 256, 256, 256};
                  pg8::StaticOrder S; S.init(4096, 256, OPQ(F.G), OPQ(cshift));
                  EpiCmp2 E{(bf16*)(opq_ptr(args.ws) + WS_CMP) + (size_t)kv * 4096 * 64, kv == 0 ? opq_ptr(args.in[6]) + (size_t)l * 4 * 64 + 64 : nullptr};
                  pg8::gemm_phase<EpiCmp2, pg8::StaticOrder, true, true>(F.lds + RING_OFF, g, S, E, F.wave); }
            }
            __syncthreads();
            { int tid_a; asm volatile("v_mbcnt_lo_u32_b32 %0, -1, 0\n\tv_mbcnt_hi_u32_b32 %0, -1, %0" : "=v"(tid_a)); tid_a += F.wave * 64;
              att::moba_phase(F.lds + RING_OFF, tid_a, F.wave, OPQ(F.vcu), OPQ(F.G), opq_ptr(args.ws), l, (bf16*)opq_ptr(args.out), 2 * l);
            }
            SEAM(pb + 3);
        }
        if (EN(4) && IN(pb + 4)) {
            { int tid_a; asm volatile("v_mbcnt_lo_u32_b32 %0, -1, 0\n\tv_mbcnt_hi_u32_b32 %0, -1, %0" : "=v"(tid_a)); tid_a += F.wave * 64;
              att::nsa_phase(F.lds + RING_OFF, tid_a, F.wave, OPQ(F.vcu), OPQ(F.G), opq_ptr(args.ws), l, (bf16*)opq_ptr(args.out), 2 * l + 1);
            }
            SEAM(pb + 4); }
        if (EN(5) && IN(pb + 5)) {
            { pg8::Gemm g{(const bf16*)xout  , (const bf16*)(opq_ptr(args.ws) + WS_WUP) + (size_t)l * 2 * DM * 512, M, DM, DM, DM};
              pg8::StaticOrder S; S.init(M, DM, OPQ(F.G), OPQ((int)blockIdx.x));
              EpiUp2 E{(bf16*)(opq_ptr(args.ws) + WS_Y), (const unsigned char*)(opq_ptr(args.ws) + WS_SGN), (const unsigned char*)(opq_ptr(args.ws) + WS_SGM)};
              pg8::gemm_phase<EpiUp2, pg8::StaticOrder, true, true>(F.lds + RING_OFF, g, S, E, F.wave); }
            SEAM(pb + 5);
        }
        if (EN(6) && IN(pb + 6)) {
            pg8::Gemm g{(const bf16*)(opq_ptr(args.ws) + WS_Y), (const bf16*)(opq_ptr(args.ws) + WS_WOUT) + (size_t)l * DM * DM, M, DM, DM, DM}; pg8::StaticOrder S; S.init(M, DM, OPQ(F.G), OPQ((int)blockIdx.x));
            EpiResid E{nullptr, XB, SSQ, 1.0f};
            pg8::gemm_phase<EpiResid, pg8::StaticOrder, (RESID_ALIGN != 0), true>(F.lds + RING_OFF, g, S, E, F.wave);
            SEAM(pb + 6);
        }
        if (EN(7) && IN(pb + 7)) {
            pg8::Gemm g{XB, (const bf16*)(opq_ptr(args.ws) + WS_W13) + (size_t)(l * 2 + 1) * N13 * DM, M, N13, DM, DM}; pg8::StaticOrder S; S.init(M, N13, OPQ(F.G), OPQ((int)blockIdx.x));
            EpiSwiGLU E{U, rinv_fill(F.lds, SSQ, S, 11, F.wave)};
            pg8::gemm_phase<EpiSwiGLU, pg8::StaticOrder, (G1_ALIGN != 0), true>(F.lds + RING_OFF, g, S, E, F.wave);
            SEAM(pb + 7);
        }
        if (EN(8) && IN(pb + 8)) {
            pg8::Gemm g{U, (const bf16*)(opq_ptr(args.ws) + WS_W2) + (size_t)(l * 2 + 1) * DM * DFF, M, DM, DFF, DFF}; pg8::StaticOrder S; S.init(M, DM, OPQ(F.G), OPQ((int)blockIdx.x));
            EpiResid E{l == DEPTH - 1 ? xout : nullptr, XB, SSQ, 0.5f};
            pg8::gemm_phase<EpiResid, pg8::StaticOrder, (RESID_ALIGN != 0), true, G2_AUX>(F.lds + RING_OFF, g, S, E, F.wave);
            SEAM(pb + 8);
        }
    }
    if (!MK_ONE_LAUNCH) launch_done((gu32*)(opq_ptr(args.ws) + WS_CTL), args.seq);
#undef IN
#undef SEAM
#undef XB
#undef SSQ
#undef U
#undef xout
}

extern "C" void kernel_launch(void* const* d_in, const int* in_sizes, int n_in, void* d_out, int out_size, void* d_ws, size_t ws_size, hipStream_t stream) {
    static int grid = 0;
    if (grid == 0) {
        if (n_in != 14 || in_sizes[0] != M * DM || out_size != M * DM || ws_size < WS_END) { fprintf(stderr, "kernel_launch: unexpected shapes (n_in %d, in0 %d, out %d, ws %zu); nothing launched\n", n_in, n_in > 0 ? in_sizes[0] : -1, out_size, ws_size); grid = -1; return; }
        int dev = 0, cus = 0, per_cu = 0;
        if (hipGetDevice(&dev) != hipSuccess || hipDeviceGetAttribute(&cus, hipDeviceAttributeMultiprocessorCount, dev) != hipSuccess) { grid = -1; return; }
        if (hipFuncSetAttribute((const void*)fwd_kernel, hipFuncAttributeMaxDynamicSharedMemorySize, LDS_BYTES) != hipSuccess) { fprintf(stderr, "kernel_launch: hipFuncSetAttribute failed\n"); grid = -1; return; }
        if (hipOccupancyMaxActiveBlocksPerMultiprocessor(&per_cu, (const void*)fwd_kernel, NWAVES * 64, LDS_BYTES) != hipSuccess || per_cu < 1)
            fprintf(stderr, "kernel_launch: note: occupancy query reports %d workgroups per CU\n", per_cu);
        (void)hipGetLastError();
        grid = cus;
    }
    if (grid < 0) return;
    if (hipMemsetAsync((char*)d_ws + WS_CTL, 0, CTL_ZERO_BYTES, stream) != hipSuccess) return;
    Args a{};
    for (int i = 0; i < 14; ++i) a.in[i] = (const float*)d_in[i];
    a.out = (float*)d_out; a.ws = (unsigned char*)d_ws;
    a.ph_lo = 0; a.ph_hi = N_PHASES;
    hipLaunchKernelGGL(fwd_kernel, dim3(grid), dim3(NWAVES * 64), LDS_BYTES, stream, a);
}
```
